# Optimizing an MI355X kernel written in HIP

```python
import math
import jax, jax.numpy as jnp
from jax import lax
import numpy as np

D_MODEL = 1024
BATCH = 4
SEQ = 4096
DEPTH = 1
DEC_BATCH = 128
DEC_SEQ = 1
PAST_LEN = 8192
PAGE_SIZE = 128

D_MIX = D_MODEL
ATTN_WIDTH = D_MIX // 2
SSM_WIDTH = D_MIX - ATTN_WIDTH
HEAD_DIM = 64
N_HEADS = ATTN_WIDTH // HEAD_DIM
N_KV_HEADS = 2
KV_REP = N_HEADS // N_KV_HEADS
WINDOW = 128
ATTN_SCALE = HEAD_DIM ** -0.5
N_BUCKETS = 32
MAX_DISTANCE = 128
SSM_HEAD_DIM = 64
SSM_HEADS = SSM_WIDTH // SSM_HEAD_DIM
SSM_GROUPS = 2
SSM_REP = SSM_HEADS // SSM_GROUPS
D_STATE = 128
CONV_W = 4
CONV_DIM = SSM_WIDTH + 2 * SSM_GROUPS * D_STATE
SSD_CHUNK = 128
D_FF = -(-(8 * D_MODEL) // (3 * 256)) * 256
Q_COLS = N_HEADS * HEAD_DIM
KV_COLS = N_KV_HEADS * HEAD_DIM
SPLIT_IDX = (Q_COLS, Q_COLS + KV_COLS, Q_COLS + 2 * KV_COLS, Q_COLS + 2 * KV_COLS + SSM_WIDTH, Q_COLS + 2 * KV_COLS + SSM_WIDTH + CONV_DIM)
D_IN_PROJ = Q_COLS + 2 * KV_COLS + SSM_WIDTH + CONV_DIM + SSM_HEADS
EPS = 1e-6

kernel_name = "hymba_swa_sink_ssd_decode_step"


def rms_norm(x, w):
    xf = x.astype(jnp.float32)
    xf = xf * lax.rsqrt(jnp.mean(xf * xf, axis=-1, keepdims=True) + EPS)
    return (xf * w.astype(jnp.float32)).astype(x.dtype)


def rel_pos_bias(dist, rel_bias):
    n = jnp.maximum(dist, 0)
    exact = N_BUCKETS // 2
    nf = jnp.maximum(n, 1).astype(jnp.float32)
    large = exact + (jnp.log(nf / exact) / math.log(MAX_DISTANCE / exact) * (N_BUCKETS - exact)).astype(jnp.int32)
    bucket = jnp.where(n < exact, n, jnp.minimum(large, N_BUCKETS - 1))
    b = rel_bias[bucket].astype(jnp.float32)
    return jnp.transpose(b, (2, 0, 1)).reshape(N_KV_HEADS, KV_REP, dist.shape[0], dist.shape[1])


def sink_softmax(s, sinks, mask):
    s = jnp.where(mask, s, -jnp.inf)
    sk = sinks.astype(jnp.float32).reshape(N_KV_HEADS, KV_REP, 1, 1)
    m = jnp.maximum(jnp.max(s, axis=-1, keepdims=True), sk)
    e = jnp.exp(s - m)
    return e / (jnp.sum(e, axis=-1, keepdims=True) + jnp.exp(sk - m))


def swa_prompt(q, k, v, sinks, rel_bias):
    b, L = q.shape[0], q.shape[1]
    nb = L // WINDOW
    qb = q.reshape(b, nb, WINDOW, N_KV_HEADS, KV_REP, HEAD_DIM)
    kb = k.reshape(b, nb, WINDOW, N_KV_HEADS, HEAD_DIM)
    vb = v.reshape(b, nb, WINDOW, N_KV_HEADS, HEAD_DIM)
    pad = ((0, 0), (1, 0), (0, 0), (0, 0), (0, 0))
    kc = jnp.concatenate([jnp.pad(kb[:, :-1], pad), kb], axis=2)
    vc = jnp.concatenate([jnp.pad(vb[:, :-1], pad), vb], axis=2)
    qi = jnp.arange(WINDOW)[:, None]
    kj = jnp.arange(2 * WINDOW)[None, :]
    dist = qi + WINDOW - kj
    band = (dist >= 0) & (dist < WINDOW)
    has_prev = (jnp.arange(nb) > 0)[:, None, None] | (kj >= WINDOW)[None]
    mask = (band[None] & has_prev)[None, :, None, None]
    s = jnp.einsum('bnqhrd,bnkhd->bnhrqk', qb, kc).astype(jnp.float32) * ATTN_SCALE + rel_pos_bias(dist, rel_bias)
    p = sink_softmax(s, sinks, mask)
    o = jnp.einsum('bnhrqk,bnkhd->bnqhrd', p.astype(vc.dtype), vc)
    return o.reshape(b, L, ATTN_WIDTH)


def swa_sample(q, k, v, k_buf, v_buf, sinks, rel_bias):
    b, S = q.shape[0], q.shape[1]
    kc = jnp.concatenate([k_buf.astype(k.dtype), k], axis=1)
    vc = jnp.concatenate([v_buf.astype(v.dtype), v], axis=1)
    dist = jnp.arange(S)[:, None] + WINDOW - jnp.arange(WINDOW + S)[None, :]
    mask = (dist >= 0) & (dist < WINDOW)
    s = jnp.einsum('bqhrd,bkhd->bhrqk', q, kc).astype(jnp.float32) * ATTN_SCALE + rel_pos_bias(dist, rel_bias)
    p = sink_softmax(s, sinks, mask)
    o = jnp.einsum('bhrqk,bkhd->bqhrd', p.astype(vc.dtype), vc)
    return o.reshape(b, S, ATTN_WIDTH), kc[:, -WINDOW:], vc[:, -WINDOW:]


def causal_conv(xbc, conv_buf, w, bias):
    L = xbc.shape[1]
    xp = jnp.concatenate([conv_buf.astype(xbc.dtype), xbc], axis=1)
    out = bias + sum(xp[:, j:j + L] * w[j] for j in range(CONV_W))
    return jax.nn.silu(out), xp[:, -(CONV_W - 1):]


def segsum_exp(cs):
    q = cs.shape[-1]
    causal = jnp.tril(jnp.ones((q, q), dtype=bool))
    return jnp.exp(jnp.where(causal, cs[..., :, None] - cs[..., None, :], -jnp.inf))


def ssd(x, dt, A, B, C, h0):
    b, L = x.shape[0], x.shape[1]
    q = min(SSD_CHUNK, L)
    nc = -(-L // q)
    pad = nc * q - L
    if pad:
        padf = lambda t: jnp.pad(t, [(0, 0), (0, pad)] + [(0, 0)] * (t.ndim - 2))
        x, dt, B, C = padf(x), padf(dt), padf(B), padf(C)
    x = x.reshape(b, nc, q, SSM_GROUPS, SSM_REP, SSM_HEAD_DIM)
    dt = dt.reshape(b, nc, q, SSM_GROUPS, SSM_REP)
    B = B.reshape(b, nc, q, SSM_GROUPS, D_STATE)
    C = C.reshape(b, nc, q, SSM_GROUPS, D_STATE)
    cs = jnp.cumsum(jnp.moveaxis(dt * A.reshape(SSM_GROUPS, SSM_REP), 2, -1), axis=-1)
    xdt = x * dt[..., None]
    CB = jnp.einsum('bcign,bcjgn->bcgij', C, B)
    M = CB[:, :, :, None] * segsum_exp(cs)
    y_diag = jnp.einsum('bcgrij,bcjgrp->bcigrp', M, xdt)
    decay_to_end = jnp.exp(cs[..., -1:] - cs)
    chunk_states = jnp.einsum('bcjgn,bcgrj,bcjgrp->bcgrpn', B, decay_to_end, xdt)
    chunk_decay = jnp.exp(cs[..., -1])

    def step(h, inp):
        st, dec = inp
        return h * dec[..., None, None] + st, h

    h_final, h_prev = lax.scan(step, h0.reshape(b, SSM_GROUPS, SSM_REP, SSM_HEAD_DIM, D_STATE),
                               (jnp.moveaxis(chunk_states, 1, 0), jnp.moveaxis(chunk_decay, 1, 0)))
    h_prev = jnp.moveaxis(h_prev, 0, 1)
    y_off = jnp.einsum('bcign,bcgri,bcgrpn->bcigrp', C, jnp.exp(cs), h_prev)
    y = (y_diag + y_off).reshape(b, nc * q, SSM_HEADS, SSM_HEAD_DIM)[:, :L]
    return y, h_final.reshape(b, SSM_HEADS, SSM_HEAD_DIM, D_STATE)


def ssm_mixer(z, xbc, dt_raw, conv_buf, h0, conv_w, conv_b, dt_bias, A_log, D_skip, norm_w):
    b, L = z.shape[0], z.shape[1]
    xbc_c, new_buf = causal_conv(xbc, conv_buf, conv_w, conv_b)
    xs, Bm, Cm = jnp.split(xbc_c.astype(jnp.float32), (SSM_WIDTH, SSM_WIDTH + SSM_GROUPS * D_STATE), axis=-1)
    xs = xs.reshape(b, L, SSM_HEADS, SSM_HEAD_DIM)
    Bm = Bm.reshape(b, L, SSM_GROUPS, D_STATE)
    Cm = Cm.reshape(b, L, SSM_GROUPS, D_STATE)
    dt = jax.nn.softplus(dt_raw.astype(jnp.float32) + dt_bias.astype(jnp.float32))
    A = -jnp.exp(A_log.astype(jnp.float32))
    y, h = ssd(xs, dt, A, Bm, Cm, h0.astype(jnp.float32))
    y = y + xs * D_skip.astype(jnp.float32)[:, None]
    y = y.reshape(b, L, SSM_WIDTH) * jax.nn.silu(z.astype(jnp.float32))
    yg = y.reshape(b, L, SSM_GROUPS, SSM_WIDTH // SSM_GROUPS)
    yg = yg * lax.rsqrt(jnp.mean(yg * yg, axis=-1, keepdims=True) + EPS)
    y = yg.reshape(b, L, SSM_WIDTH) * norm_w.astype(jnp.float32)
    return y.astype(z.dtype), new_buf, h


def hybrid_layer(x, k_buf, v_buf, conv_buf, h0, rel_bias, norm1_w, w_in, attn_sinks, conv_w, conv_b,
                 dt_bias, A_log, D_skip, ssm_norm_w, w_out, norm2_w, w_gate, w_up, w_down):
    b, L = x.shape[0], x.shape[1]
    h = rms_norm(x, norm1_w)
    proj = h @ w_in
    q, k, v, z, xbc, dt_raw = jnp.split(proj, SPLIT_IDX, axis=-1)
    q = q.reshape(b, L, N_KV_HEADS, KV_REP, HEAD_DIM)
    k = k.reshape(b, L, N_KV_HEADS, HEAD_DIM)
    v = v.reshape(b, L, N_KV_HEADS, HEAD_DIM)
    if k_buf is None:
        a = swa_prompt(q, k, v, attn_sinks, rel_bias)
        new_k, new_v = k[:, -WINDOW:], v[:, -WINDOW:]
    else:
        a, new_k, new_v = swa_sample(q, k, v, k_buf, v_buf, attn_sinks, rel_bias)
    s_out, new_conv, new_h = ssm_mixer(z, xbc, dt_raw, conv_buf, h0, conv_w, conv_b, dt_bias, A_log, D_skip, ssm_norm_w)
    x = x + jnp.concatenate([a, s_out], axis=-1) @ w_out
    h2 = rms_norm(x, norm2_w)
    x = x + (jax.nn.silu(h2 @ w_gate) * (h2 @ w_up)) @ w_down
    return x, new_k, new_v, new_conv, new_h


def setup_inputs(seed: int = 0) -> dict:
    key = jax.random.key(seed)
    ks = jax.random.split(key, 24)
    f32 = jnp.float32

    def nrm(k, shape, s):
        return jax.random.normal(k, shape, f32) * s

    dt0 = jnp.exp(jax.random.uniform(ks[12], (DEPTH, SSM_HEADS), f32, math.log(1e-3), math.log(1e-1)))
    return {
        "x_prompt": nrm(ks[0], (BATCH, SEQ, D_MODEL), 1.0),
        "x_sample": nrm(ks[1], (DEC_BATCH, DEC_SEQ, D_MODEL), 1.0),
        "cache_k": nrm(ks[2], (DEPTH, DEC_BATCH, WINDOW, N_KV_HEADS, HEAD_DIM), 1.0),
        "cache_v": nrm(ks[3], (DEPTH, DEC_BATCH, WINDOW, N_KV_HEADS, HEAD_DIM), 1.0),
        "state_conv": nrm(ks[4], (DEPTH, DEC_BATCH, CONV_W - 1, CONV_DIM), 1.0),
        "state_ssm": nrm(ks[5], (DEPTH, DEC_BATCH, SSM_HEADS, SSM_HEAD_DIM, D_STATE), 0.5),
        "rel_bias": nrm(ks[6], (N_BUCKETS, N_HEADS), 0.5),
        "norm1_w": 1.0 + nrm(ks[7], (DEPTH, D_MODEL), 0.02),
        "w_in": nrm(ks[8], (DEPTH, D_MODEL, D_IN_PROJ), D_MODEL ** -0.5),
        "attn_sinks": nrm(ks[9], (DEPTH, N_HEADS), 1.0),
        "conv_w": nrm(ks[10], (DEPTH, CONV_W, CONV_DIM), CONV_W ** -0.5),
        "conv_b": nrm(ks[11], (DEPTH, CONV_DIM), 0.02),
        "dt_bias": dt0 + jnp.log(-jnp.expm1(-dt0)),
        "A_log": jnp.log(jax.random.uniform(ks[13], (DEPTH, SSM_HEADS), f32, 1.0, 16.0)),
        "D_skip": 1.0 + nrm(ks[14], (DEPTH, SSM_HEADS), 0.1),
        "ssm_norm_w": 1.0 + nrm(ks[15], (DEPTH, SSM_WIDTH), 0.02),
        "w_out": nrm(ks[16], (DEPTH, D_MIX, D_MODEL), D_MIX ** -0.5),
        "norm2_w": 1.0 + nrm(ks[17], (DEPTH, D_MODEL), 0.02),
        "w_gate": nrm(ks[18], (DEPTH, D_MODEL, D_FF), D_MODEL ** -0.5),
        "w_up": nrm(ks[19], (DEPTH, D_MODEL, D_FF), D_MODEL ** -0.5),
        "w_down": nrm(ks[20], (DEPTH, D_FF, D_MODEL), D_FF ** -0.5),
        "final_norm_w": 1.0 + nrm(ks[21], (D_MODEL,), 0.02),
    }


def reference(x_prompt, x_sample, cache_k, cache_v, state_conv, state_ssm, rel_bias, norm1_w, w_in,
              attn_sinks, conv_w, conv_b, dt_bias, A_log, D_skip, ssm_norm_w, w_out, norm2_w,
              w_gate, w_up, w_down, final_norm_w):
    yp, ys = x_prompt, x_sample
    kp, vp, cp, sp, kss, vss, css, sss = [], [], [], [], [], [], [], []
    conv0 = jnp.zeros((x_prompt.shape[0], CONV_W - 1, CONV_DIM), x_prompt.dtype)
    h00 = jnp.zeros((x_prompt.shape[0], SSM_HEADS, SSM_HEAD_DIM, D_STATE), jnp.float32)
    for l in range(DEPTH):
        wts = (rel_bias, norm1_w[l], w_in[l], attn_sinks[l], conv_w[l], conv_b[l], dt_bias[l], A_log[l],
               D_skip[l], ssm_norm_w[l], w_out[l], norm2_w[l], w_gate[l], w_up[l], w_down[l])
        yp, k1, v1, c1, s1 = hybrid_layer(yp, None, None, conv0, h00, *wts)
        ys, k2, v2, c2, s2 = hybrid_layer(ys, cache_k[l], cache_v[l], state_conv[l], state_ssm[l], *wts)
        kp.append(k1.astype(cache_k.dtype)); vp.append(v1.astype(cache_v.dtype))
        cp.append(c1.astype(state_conv.dtype)); sp.append(s1.astype(state_ssm.dtype))
        kss.append(k2.astype(cache_k.dtype)); vss.append(v2.astype(cache_v.dtype))
        css.append(c2.astype(state_conv.dtype)); sss.append(s2.astype(state_ssm.dtype))
    yp = rms_norm(yp, final_norm_w)
    ys = rms_norm(ys, final_norm_w)
    return (yp, ys, jnp.stack(kp), jnp.stack(vp), jnp.stack(cp), jnp.stack(sp),
            jnp.stack(kss), jnp.stack(vss), jnp.stack(css), jnp.stack(sss))
```

```cpp
#include <hip/hip_runtime.h>
#include <cstdio>
#include <cstdint>
namespace pg8 {
#define PG8_LAS __attribute__((address_space(3)))
typedef unsigned short bf16_t;
typedef short bf16x8 __attribute__((ext_vector_type(8)));
typedef float f32x4 __attribute__((ext_vector_type(4)));
typedef unsigned u32x4 __attribute__((ext_vector_type(4)));
constexpr int BM = 256, BK = 64, HALF = 128, HTB = HALF * BK * 2  , STAGE_BYTES = 8 * HTB, NXCD = 8, WGM = 8;

__host__ __device__ __forceinline__ int lds_byte(int r, int c) { const int st = (r >> 4) * 2 + (c >> 5), rr = r & 15, cc = c & 31, ob = rr * 64 + cc * 2; return st * 1024 + (ob ^ (((ob >> 9) & 1) << 5)); }
__host__ __device__ __forceinline__ void stage_rc(int b, int& R, int& C) { const int st = b / 1024, sb = b % 1024, swz = sb ^ (((sb >> 9) & 1) << 5); R = (st >> 1) * 16 + swz / 64; C = (st & 1) * 32 + (swz % 64) / 2; }
__host__ __device__ __forceinline__ int perm32(int rho) { const int n = rho >> 4, i = rho & 15; return 8 * (i >> 2) + 4 * n + (i & 3); }

struct Unit { int pm, pn; };
struct Gemm { const bf16_t* A; const bf16_t* Bt; int M, N, K; };

struct StaticOrder {
    int nM, nN, nwg, G, c;
    __host__ __device__ void init(int M, int N, int G_, int c_) { nM = M / BM; nN = N / BM; nwg = nM * nN; G = G_; c = c_; }
    __host__ __device__ bool next(int i, Unit& u) const {
        const long L = (long)i * G + c; if (L >= nwg) return false;
        int wgid = (int)L; { const int q = nwg / NXCD, r = nwg % NXCD, xcd = wgid % NXCD, off = wgid / NXCD; wgid = (xcd < r ? xcd * (q + 1) : r * (q + 1) + (xcd - r) * q) + off; }
        const int nig = WGM * nN, gid = wgid / nig, fm = gid * WGM, gsz = (nM - fm) < WGM ? (nM - fm) : WGM;
        u.pm = fm + ((wgid % nig) % gsz); u.pn = (wgid % nig) / gsz; return true;
    }
    __device__ __forceinline__ void a_ready(const Unit&) const {}
    __device__ __forceinline__ void done(const Unit&) const {}
};

__device__ __forceinline__ unsigned cvt_pk_bf16(float lo, float hi) { unsigned r; asm volatile("v_cvt_pk_bf16_f32 %0, %1, %2" : "=v"(r) : "v"(lo), "v"(hi)); return r; }
typedef unsigned u32x2 __attribute__((ext_vector_type(2)));
struct EpiStoreBf16 {
    static constexpr bool PERM = true, AFTER_DRAIN = false;
    bf16_t* O; int ldc;
    __device__ __forceinline__ void operator()(const f32x4 (&acc)[2][2][4][2], const Unit& u, int wr, int wc, int fr, int fq) const {
        const int row0 = u.pm * BM + wr * 64 + fr, col0 = u.pn * BM + wc * 32 + 8 * fq;
#pragma unroll
        for (int ai = 0; ai < 2; ++ai)
#pragma unroll
            for (int m = 0; m < 4; ++m) { bf16_t* rowp = O + (size_t)(row0 + ai * HALF + m * 16) * ldc + col0;
#pragma unroll
                for (int bj = 0; bj < 2; ++bj) { const f32x4 v0 = acc[ai][bj][m][0], v1 = acc[ai][bj][m][1];
                    u32x4 w; w.x = cvt_pk_bf16(v0[0], v0[1]); w.y = cvt_pk_bf16(v0[2], v0[3]); w.z = cvt_pk_bf16(v1[0], v1[1]); w.w = cvt_pk_bf16(v1[2], v1[3]);
                    *(u32x4*)(rowp + bj * HALF) = w; } }
    }
};
struct EpiResid {
    static constexpr bool PERM = false, AFTER_DRAIN = false;
    const float* base0; const float* base1; int split; float* out; bf16_t* xb; float* ssq; int mreal;
    __device__ __forceinline__ void operator()(const f32x4 (&acc)[2][2][4][2], const Unit& u, int wr, int wc, int fr, int fq) const {
        const int col0 = u.pn * BM + wc * 32 + 4 * fq;
#pragma unroll
        for (int ai = 0; ai < 2; ++ai)
#pragma unroll
            for (int m = 0; m < 4; ++m) { const int row = u.pm * BM + ai * HALF + wr * 64 + m * 16 + fr;
                float s = 0.f;
                if (row < mreal) {
                    const float* bp = (row < split ? base0 + (size_t)row * 1024 : base1 + (size_t)(row - split) * 1024) + col0;
                    float* op = out + (size_t)row * 1024 + col0;
#pragma unroll
                    for (int bj = 0; bj < 2; ++bj)
#pragma unroll
                        for (int n = 0; n < 2; ++n) { const f32x4 v = *(const f32x4*)(bp + bj * HALF + n * 16) + acc[ai][bj][m][n];
                            *(f32x4*)(op + bj * HALF + n * 16) = v; s += (v[0] * v[0] + v[1] * v[1]) + (v[2] * v[2] + v[3] * v[3]);
                            if (xb) { u32x2 w; w.x = cvt_pk_bf16(v[0], v[1]); w.y = cvt_pk_bf16(v[2], v[3]); *(u32x2*)(xb + (size_t)row * 1024 + col0 + bj * HALF + n * 16) = w; } }
                }
                if (ssq) { s += __shfl_xor(s, 16); s += __shfl_xor(s, 32); if (fq == 0 && row < mreal) ssq[(size_t)row * 16 + u.pn * 4 + wc] = s; }
            }
    }
};
struct EpiSwiglu {
    static constexpr bool PERM = true, AFTER_DRAIN = false;
    bf16_t* H; int ldh; const float* ssq; float eps;
    __device__ __forceinline__ void operator()(const f32x4 (&acc)[2][2][4][2], const Unit& u, int wr, int wc, int fr, int fq) const {
        const int row0 = u.pm * BM + wr * 64 + fr, hcol0 = (u.pn * BM + wc * 32 + 8 * fq) >> 1;
#pragma unroll
        for (int ai = 0; ai < 2; ++ai)
#pragma unroll
            for (int m = 0; m < 4; ++m) { const int row = row0 + ai * HALF + m * 16;
                const f32x4* sp = (const f32x4*)(ssq + (size_t)row * 16); const f32x4 s0 = sp[0], s1 = sp[1], s2 = sp[2], s3 = sp[3];
                const float sum = ((s0[0] + s0[1]) + (s0[2] + s0[3])) + ((s1[0] + s1[1]) + (s1[2] + s1[3])) + ((s2[0] + s2[1]) + (s2[2] + s2[3])) + ((s3[0] + s3[1]) + (s3[2] + s3[3]));
                const float rstd = 1.0f / sqrtf(sum * (1.0f / 1024.0f) + eps);
#pragma unroll
                for (int bj = 0; bj < 2; ++bj) { const f32x4 g = acc[ai][bj][m][0] * rstd, up = acc[ai][bj][m][1] * rstd; float hv[4];
#pragma unroll
                    for (int e = 0; e < 4; ++e) hv[e] = g[e] * __builtin_amdgcn_rcpf(1.0f + __expf(-g[e])) * up[e];
                    u32x2 w; w.x = cvt_pk_bf16(hv[0], hv[1]); w.y = cvt_pk_bf16(hv[2], hv[3]);
                    *(u32x2*)(H + (size_t)row * ldh + hcol0 + bj * (HALF / 2)) = w; } }
    }
};
template <class Epi, class Sched, bool ALIGN_EPI = false, bool SP2 = false>
__device__ __forceinline__ void gemm_phase(PG8_LAS unsigned char* lds, const Gemm g, const Sched& S, const Epi& E) {
    const int tid = threadIdx.x, wid = __builtin_amdgcn_readfirstlane(tid >> 6), lane = tid & 63, wr = wid >> 2, wc = wid & 3, fr = lane & 15, fq = lane >> 4;
    const int K = g.K, nt = K / BK;
    unsigned voffA[2], voffB[2];
#pragma unroll
    for (int i = 0; i < 2; ++i) { int R, C; stage_rc(tid * 16 + i * 8192, R, C); const int Rb = Epi::PERM ? ((R & ~31) + perm32(R & 31)) : R;
        voffA[i] = (unsigned)(R * K + C) * 2u; voffB[i] = (unsigned)(Rb * K + C) * 2u; }
    const size_t kstep = (size_t)(BK * 2);
    const size_t hstep = (size_t)HALF * K * 2;
    const size_t tstep = 2 * hstep;
    const unsigned ldsw = (unsigned)wid * 1024u;
    const int aoff = lds_byte(wr * 64 + fr, fq * 8), boff = lds_byte(wc * 32 + fr, fq * 8);
#define PG8_SA(b, h) (((b) * 2 + (h)) * HTB)
#define PG8_SB(b, h) ((4 + (b) * 2 + (h)) * HTB)
#define PG8_STAGE(bufoff, gbase, voff) do { _Pragma("unroll") for (int _i = 0; _i < 2; ++_i) \
        __builtin_amdgcn_global_load_lds((const unsigned*)((const char*)(gbase) + (voff)[_i]), (PG8_LAS unsigned*)(lds + (bufoff) + ldsw + _i * 8192), 16, 0, 0); } while (0)
#define PG8_LDA(dst, b, h) do { _Pragma("unroll") for (int m = 0; m < 4; ++m) _Pragma("unroll") for (int k = 0; k < 2; ++k) dst[m][k] = *(const PG8_LAS bf16x8*)(lds + PG8_SA(b, h) + aoff + m * 2048 + k * 1024); } while (0)
#define PG8_LDB(dst, b, h) do { _Pragma("unroll") for (int n = 0; n < 2; ++n) _Pragma("unroll") for (int k = 0; k < 2; ++k) dst[n][k] = *(const PG8_LAS bf16x8*)(lds + PG8_SB(b, h) + boff + n * 2048 + k * 1024); } while (0)
#define PG8_MMA(ai, bj, At, Bt) do { __builtin_amdgcn_s_setprio(1); _Pragma("unroll") for (int m = 0; m < 4; ++m) _Pragma("unroll") for (int n = 0; n < 2; ++n) _Pragma("unroll") for (int k = 0; k < 2; ++k) \
        acc[ai][bj][m][n] = __builtin_amdgcn_mfma_f32_16x16x32_bf16(Bt[n][k], At[m][k], acc[ai][bj][m][n], 0, 0, 0); __builtin_amdgcn_s_setprio(0); } while (0)
#define PG8_WAIT_V(n) asm volatile("s_waitcnt vmcnt(" #n ")" ::: "memory")
#define PG8_WAIT_L(n) asm volatile("s_waitcnt lgkmcnt(" #n ")" ::: "memory")
#define PG8_BAR __builtin_amdgcn_s_barrier()
#define PG8_SCHED __builtin_amdgcn_sched_barrier(0)
    Unit cur, nxt; int ui = 0;
    if (!S.next(0, cur)) return;
    f32x4 acc[2][2][4][2];
#pragma unroll
    for (int a = 0; a < 2; ++a)
#pragma unroll
        for (int b = 0; b < 2; ++b)
#pragma unroll
            for (int m = 0; m < 4; ++m)
#pragma unroll
                for (int n = 0; n < 2; ++n) acc[a][b][m][n] = (f32x4){0.f, 0.f, 0.f, 0.f};
    bf16x8 At[4][2], B0[2][2], B1[2][2];
    const char* cA = (const char*)g.A + (size_t)cur.pm * tstep; const char* cB = (const char*)g.Bt + (size_t)cur.pn * tstep;
    S.a_ready(cur);
    if constexpr (SP2) {
        PG8_STAGE(PG8_SB(0, 0), cB, voffB); PG8_STAGE(PG8_SB(0, 1), cB + hstep, voffB); PG8_STAGE(PG8_SA(0, 0), cA, voffA); PG8_STAGE(PG8_SA(0, 1), cA + hstep, voffA);
        if (wr == 1) PG8_BAR;
        PG8_WAIT_V(2); PG8_BAR;
        PG8_STAGE(PG8_SB(1, 0), cB + kstep, voffB); PG8_STAGE(PG8_SA(1, 0), cA + kstep, voffA); PG8_STAGE(PG8_SB(1, 1), cB + hstep + kstep, voffB);
        PG8_WAIT_V(6); PG8_BAR;
    } else {
        PG8_STAGE(PG8_SB(0, 0), cB, voffB); PG8_STAGE(PG8_SA(0, 0), cA, voffA); PG8_STAGE(PG8_SB(0, 1), cB + hstep, voffB); PG8_STAGE(PG8_SA(0, 1), cA + hstep, voffA);
        if (wr == 1) PG8_BAR;
        PG8_WAIT_V(4); PG8_BAR;
        PG8_STAGE(PG8_SB(1, 0), cB + kstep, voffB); PG8_STAGE(PG8_SA(1, 0), cA + kstep, voffA); PG8_STAGE(PG8_SB(1, 1), cB + hstep + kstep, voffB);
        PG8_WAIT_V(6); PG8_BAR;
    }
    for (;;) {
        const bool has_next = S.next(ui + 1, nxt);
        const char* nA = has_next ? (const char*)g.A + (size_t)nxt.pm * tstep : cA; const char* nB = has_next ? (const char*)g.Bt + (size_t)nxt.pn * tstep : cB;
        for (int t = 0; t < nt; t += 2) {
            const bool last = (t == nt - 2);
            const char* a1 = cA + (size_t)(t + 1) * kstep;
            const char* a2 = last ? nA : cA + (size_t)(t + 2) * kstep; const char* b2 = last ? nB : cB + (size_t)(t + 2) * kstep;
            const char* a3 = a2 + kstep; const char* b3 = b2 + kstep;
            if (last && has_next) S.a_ready(nxt);
            if constexpr (SP2) {
            PG8_LDB(B0, 0, 0); PG8_LDB(B1, 0, 1); PG8_SCHED; PG8_LDA(At, 0, 0); PG8_STAGE(PG8_SA(1, 1), a1 + hstep, voffA);
            PG8_WAIT_V(8); PG8_WAIT_L(0); PG8_BAR; PG8_MMA(0, 0, At, B0); PG8_MMA(0, 1, At, B1); PG8_BAR; PG8_SCHED;
            PG8_LDA(At, 0, 1); PG8_STAGE(PG8_SB(0, 0), b2, voffB); PG8_STAGE(PG8_SB(0, 1), b2 + hstep, voffB); PG8_STAGE(PG8_SA(0, 0), a2, voffA);
            PG8_WAIT_V(8); PG8_WAIT_L(0); PG8_BAR; PG8_MMA(1, 0, At, B0); PG8_MMA(1, 1, At, B1); PG8_BAR; PG8_SCHED;
            PG8_LDB(B0, 1, 0); PG8_LDB(B1, 1, 1); PG8_SCHED; PG8_LDA(At, 1, 0); PG8_STAGE(PG8_SA(0, 1), a2 + hstep, voffA);
            PG8_WAIT_V(8); PG8_WAIT_L(0); PG8_BAR; PG8_MMA(0, 0, At, B0); PG8_MMA(0, 1, At, B1); PG8_BAR; PG8_SCHED;
            PG8_LDA(At, 1, 1); PG8_STAGE(PG8_SB(1, 0), b3, voffB); PG8_STAGE(PG8_SB(1, 1), b3 + hstep, voffB); PG8_STAGE(PG8_SA(1, 0), a3, voffA);
            PG8_WAIT_V(8); PG8_WAIT_L(0); PG8_BAR; PG8_MMA(1, 0, At, B0); PG8_MMA(1, 1, At, B1); PG8_BAR; PG8_SCHED;
            } else {
            PG8_LDB(B0, 0, 0); PG8_SCHED; PG8_LDA(At, 0, 0); PG8_STAGE(PG8_SA(1, 1), a1 + hstep, voffA);
            PG8_WAIT_L(8); PG8_BAR; PG8_WAIT_L(0); PG8_MMA(0, 0, At, B0); PG8_BAR; PG8_SCHED;
            PG8_LDB(B1, 0, 1); PG8_STAGE(PG8_SB(0, 0), b2, voffB);
            PG8_BAR; PG8_WAIT_L(0); PG8_MMA(0, 1, At, B1); PG8_BAR;
            PG8_LDA(At, 0, 1); PG8_STAGE(PG8_SA(0, 0), a2, voffA);
            PG8_BAR; PG8_WAIT_L(0); PG8_MMA(1, 0, At, B0); PG8_BAR; PG8_SCHED;
            PG8_STAGE(PG8_SB(0, 1), b2 + hstep, voffB);
            PG8_WAIT_V(6); PG8_BAR; PG8_MMA(1, 1, At, B1); PG8_BAR;
            PG8_LDB(B0, 1, 0); PG8_SCHED; PG8_LDA(At, 1, 0); PG8_STAGE(PG8_SA(0, 1), a2 + hstep, voffA);
            PG8_WAIT_L(8); PG8_BAR; PG8_WAIT_L(0); PG8_MMA(0, 0, At, B0); PG8_BAR; PG8_SCHED;
            PG8_LDB(B1, 1, 1); PG8_STAGE(PG8_SB(1, 0), b3, voffB);
            PG8_BAR; PG8_WAIT_L(0); PG8_MMA(0, 1, At, B1); PG8_BAR;
            PG8_LDA(At, 1, 1); PG8_STAGE(PG8_SA(1, 0), a3, voffA);
            PG8_BAR; PG8_WAIT_L(0); PG8_MMA(1, 0, At, B0); PG8_BAR; PG8_SCHED;
            PG8_STAGE(PG8_SB(1, 1), b3 + hstep, voffB);
            PG8_WAIT_V(6); PG8_BAR; PG8_MMA(1, 1, At, B1); PG8_BAR;
            }
        }
        if constexpr (ALIGN_EPI) { if (wr == 0) PG8_BAR; }
        if constexpr (!Epi::AFTER_DRAIN) { E(acc, cur, wr, wc, fr, fq); S.done(cur); }
        if (!has_next) break;
#pragma unroll
        for (int a = 0; a < 2; ++a)
#pragma unroll
            for (int b = 0; b < 2; ++b)
#pragma unroll
                for (int m = 0; m < 4; ++m)
#pragma unroll
                    for (int n = 0; n < 2; ++n) acc[a][b][m][n] = (f32x4){0.f, 0.f, 0.f, 0.f};
        cur = nxt; cA = nA; cB = nB; ++ui;
        if constexpr (ALIGN_EPI) { if (wr == 1) PG8_BAR; }
    }
    PG8_WAIT_V(0);
    if constexpr (!ALIGN_EPI) { if (wr == 0) PG8_BAR; }
    PG8_BAR;
    if constexpr (Epi::AFTER_DRAIN) { E.fused(acc, cur, wr, wc, fr, fq, lds, wid, lane); S.done(cur); }
#undef PG8_SA
#undef PG8_SB
#undef PG8_STAGE
#undef PG8_LDA
#undef PG8_LDB
#undef PG8_MMA
#undef PG8_WAIT_V
#undef PG8_WAIT_L
#undef PG8_BAR
#undef PG8_SCHED
}
}
#define GAS __attribute__((address_space(1)))
#define LAS __attribute__((address_space(3)))
typedef unsigned short bf16;
typedef unsigned v4u __attribute__((ext_vector_type(4)));
typedef float f32x4 __attribute__((ext_vector_type(4)));
typedef short bf16x8 __attribute__((ext_vector_type(8)));
typedef GAS unsigned gu32;
typedef GAS unsigned long long gu64;
#define RLX_AGENT __ATOMIC_RELAXED, __HIP_MEMORY_SCOPE_AGENT
#define LDS_WAIT() asm volatile("s_waitcnt lgkmcnt(0)" ::: "memory")
#define VM_WAIT() asm volatile("s_waitcnt vmcnt(0)" ::: "memory")
__device__ __forceinline__ unsigned long long rt() { return __builtin_amdgcn_s_memrealtime(); }
__device__ __forceinline__ unsigned f2bf(float f) { unsigned u = __builtin_bit_cast(unsigned, f); return (u + 0x7fffu + ((u >> 16) & 1u)) >> 16; }
__device__ __forceinline__ unsigned pk2(float lo, float hi) { return f2bf(lo) | (f2bf(hi) << 16); }

#define XB_TMO      128
#define XB_XCNT(j)  (256  + 64 * (j))
#define XB_XSUB(j)  (1280 + 64 * (j))
#define XB_XGEN(j)  (2304 + 64 * (j))
#define XB_TOP      3328
#define XB_TOPGEN   3392
#define XCD_BAR_WORDS 3456
#define XB_SPIN_CAP (1u << 18)

__device__ __forceinline__ unsigned xb_ld(unsigned* p)              { return __hip_atomic_load(p, __ATOMIC_RELAXED, __HIP_MEMORY_SCOPE_AGENT); }
__device__ __forceinline__ unsigned xb_add(unsigned* p, unsigned v) { return __hip_atomic_fetch_add(p, v, __ATOMIC_RELAXED, __HIP_MEMORY_SCOPE_AGENT); }
__device__ __forceinline__ unsigned xb_xcc_id() { return (unsigned)__builtin_amdgcn_s_getreg((3 << 11) | 20) & 0xFu; }
#define XB_SPIN(cond, bar) do { unsigned _sp = 0; while (cond) { __builtin_amdgcn_s_sleep(1); \
    if ((++_sp & 255u) == 0u) { if (xb_ld(&(bar)[XB_TMO])) break; if (_sp > XB_SPIN_CAP) { atomicAdd(&(bar)[XB_TMO], 1u); break; } } } } while (0)

struct XcdBarrier {
    unsigned* bar; unsigned x;
    volatile LAS unsigned* st;
};

__device__ __forceinline__ XcdBarrier xcd_barrier_post(unsigned* bar, volatile LAS unsigned* st) {
    XcdBarrier b; b.bar = bar; b.x = xb_xcc_id(); b.st = st;
    if (threadIdx.x == 0) (void)xb_add(&bar[XB_XCNT(b.x)], 1u);
    return b;
}
__device__ __forceinline__ void xcd_barrier_complete(unsigned* bar, unsigned x, unsigned& nloc, unsigned& nx) {
    const unsigned G = gridDim.x * gridDim.y * gridDim.z;
    unsigned sum, cnt, mine, sp = 0u;
    for (;;) {
        sum = 0u; cnt = 0u; mine = 0u;
#pragma unroll
        for (unsigned j = 0; j < 16; ++j) { const unsigned c = xb_ld(&bar[XB_XCNT(j)]); sum += c; cnt += (c > 0u) ? 1u : 0u; mine = (j == x) ? c : mine; }
        if (sum == G) break;
        __builtin_amdgcn_s_sleep(1);
        if ((++sp & 255u) == 0u) { if (xb_ld(&bar[XB_TMO])) break; if (sp > XB_SPIN_CAP) { atomicAdd(&bar[XB_TMO], 1u); break; } }
    }
    nloc = mine > 0u ? mine : 1u; nx = cnt > 0u ? cnt : 1u;
}

__device__ __forceinline__ void xcd_barrier(const XcdBarrier& b) {
    asm volatile("s_waitcnt vmcnt(0)" ::: "memory");
    __syncthreads();
    if (threadIdx.x == 0) {
        unsigned* bar = b.bar;
        __builtin_amdgcn_s_waitcnt(0);
        unsigned nloc = b.st[0], nx = b.st[1];
        if (nloc == 0u) { xcd_barrier_complete(bar, b.x, nloc, nx); b.st[0] = nloc; b.st[1] = nx; }
        const unsigned old = xb_add(&bar[XB_XSUB(b.x)], 1u);
        const unsigned gen = old / nloc;
        if (old + 1u == (gen + 1u) * nloc) {
            __builtin_amdgcn_fence(__ATOMIC_RELEASE, "agent");
            asm volatile("s_waitcnt vmcnt(0)" ::: "memory");
            const unsigned og = xb_add(&bar[XB_TOP], 1u);
            const unsigned tg = og / nx;
            if (og + 1u == (tg + 1u) * nx) xb_add(&bar[XB_TOPGEN], 1u);
            else XB_SPIN(xb_ld(&bar[XB_TOPGEN]) == tg, bar);
            __builtin_amdgcn_fence(__ATOMIC_ACQUIRE, "agent");
            xb_add(&bar[XB_XGEN(b.x)], 1u);
            asm volatile("s_waitcnt vmcnt(0)" ::: "memory");
        } else {
            XB_SPIN(xb_ld(&bar[XB_XGEN(b.x)]) == gen, bar);
            __builtin_amdgcn_fence(__ATOMIC_ACQUIRE, "agent");
            asm volatile("s_waitcnt vmcnt(0)" ::: "memory");
        }
    }
    __syncthreads();
}
constexpr int NWAVES = 8;
constexpr int DM = 1024, BATCH = 4, SEQ = 4096, NB = 128  , MPROMPT = BATCH * SEQ, MREAL = MPROMPT + NB, MP = 16640  ;
constexpr int NPROJ = 2304, LDW_IN = 2312, DFF = 2816, NGU = 2 * DFF;
constexpr int C_Q = 0, C_K = 512, C_V = 640, C_Z = 768, C_XBC = 1280, C_B = 1792, C_C = 2048;
constexpr float EPS = 1e-6f;
constexpr size_t O_YP = 0, O_YS = 16777216, O_KP = 16908288, O_VP = 16973824, O_CP = 17039360, O_SP = 17051648, O_KS = 17313792, O_VS = 19410944, O_CS = 21508096, O_SS = 21901312, O_END = 30289920;
constexpr size_t MiB = 1u << 20;
constexpr size_t WS_CTL = 0, CTL_ZERO_BYTES = 1 * MiB;
constexpr size_t WS_WIN = 2 * MiB;
constexpr size_t WS_WOUT = 7 * MiB;
constexpr size_t WS_WGU = 9 * MiB;
constexpr size_t WS_WD = 20 * MiB;
constexpr size_t WS_DT = 26 * MiB;
constexpr size_t WS_SSQ1 = 27 * MiB;
constexpr size_t WS_XN = 32 * MiB;
constexpr size_t WS_PROJ = 66 * MiB;
constexpr size_t WS_MIX = 140 * MiB;
constexpr size_t WS_YS = 174 * MiB;
constexpr size_t WS_XC = 208 * MiB;
constexpr size_t WS_END = 256 * MiB;
static_assert(WS_PROJ + (size_t)MP * DFF * 2 <= WS_YS && WS_XC + (size_t)MP * 1024 * 2 <= WS_END, "ws map");
constexpr int CW_BAR = 4096;

constexpr int RING_OFF = 0, RING_BYTES = 131072;
constexpr int LDS_BYTES = 163840;
constexpr int MISC_OFF = LDS_BYTES - 256;

__device__ const unsigned char BUCKET[128] = {0, 1, 2, 3, 4, 5, 6, 7, 8, 9, 10, 11, 12, 13, 14, 15, 16, 16, 16, 17, 17, 18, 18, 18, 19, 19, 19, 20, 20, 20, 20, 21, 21, 21, 21, 22, 22, 22, 22, 22, 23, 23, 23, 23, 23, 23, 24, 24, 24, 24, 24, 24, 25, 25, 25, 25, 25, 25, 25, 26, 26, 26, 26, 26, 26, 26, 26, 27, 27, 27, 27, 27, 27, 27, 27, 27, 27, 28, 28, 28, 28, 28, 28, 28, 28, 28, 28, 29, 29, 29, 29, 29, 29, 29, 29, 29, 29, 29, 29, 30, 30, 30, 30, 30, 30, 30, 30, 30, 30, 30, 30, 30, 30, 31, 31, 31, 31, 31, 31, 31, 31, 31, 31, 31, 31, 31, 31, 31};

__device__ __forceinline__ float bf2f(unsigned short b) { return __uint_as_float((unsigned)b << 16); }
__device__ __forceinline__ float wave_sum(float v) {
#pragma unroll
    for (int o = 1; o < 64; o <<= 1) v += __shfl_xor(v, o);
    return v;
}
__device__ __forceinline__ float wave_max(float v) {
#pragma unroll
    for (int o = 1; o < 64; o <<= 1) v = fmaxf(v, __shfl_xor(v, o));
    return v;
}
__device__ __forceinline__ float silu_f(float a) { return a / (1.0f + __expf(-a)); }
__device__ __forceinline__ float softplus_f(float v) { return fmaxf(v, 0.f) + log1pf(expf(-fabsf(v))); }

struct Frame {
    LAS unsigned char* lds;
    int tid, lane, wave, G, vcu;
    const float* in[22]; float* out; unsigned char* ws;
};

template <class RowMap>
__device__ __forceinline__ void p0_transpose_item(const float* W, int ldw, int nblk, const float* kscale, bf16* WT, int ldo, RowMap rm, LAS float* scr, int item, int lane) {
    const int kb = item / nblk, nb = item % nblk, k0 = 64 * kb, n0 = 32 * nb;
#pragma unroll 8
    for (int i = 0; i < 32; ++i) { const int kk = 2 * i + (lane >> 5); float v = W[(size_t)(k0 + kk) * ldw + n0 + (lane & 31)]; if (kscale) v *= kscale[k0 + kk]; scr[kk * 33 + (lane & 31)] = v; }
    LDS_WAIT(); asm volatile("" ::: "memory");
    const int c = lane & 7;
#pragma unroll
    for (int j = 0; j < 4; ++j) { const int n = (lane >> 3) + 8 * j; const LAS float* s = scr + (8 * c) * 33 + n;
        v4u o; o.x = pk2(s[0 * 33], s[1 * 33]); o.y = pk2(s[2 * 33], s[3 * 33]); o.z = pk2(s[4 * 33], s[5 * 33]); o.w = pk2(s[6 * 33], s[7 * 33]);
        *(GAS v4u*)(WT + (size_t)rm(n0 + n) * ldo + k0 + 8 * c) = o; }
    LDS_WAIT(); asm volatile("" ::: "memory");
}
struct RmId { __device__ __forceinline__ int operator()(int n) const { return n; } };
struct RmGU { int up; __device__ __forceinline__ int operator()(int n) const { return 8 * (n >> 2) + (n & 3) + 4 * up; } };

__device__ __forceinline__ void p0_prologue(Frame& F) {
    const float* x_p = F.in[0]; const float* x_s = F.in[1]; const float* norm1 = F.in[7]; const float* w_in = F.in[8]; const float* dt_bias = F.in[12];
    bf16* XN = (bf16*)(F.ws + WS_XN); float* DT = (float*)(F.ws + WS_DT);
    LAS float* wdt = (LAS float*)(F.lds);
    LAS float* scr = (LAS float*)(F.lds + 32768 + F.wave * 12288);
    for (int i = F.tid; i < 8192; i += NWAVES * 64) { const int k = i >> 3, j = i & 7; wdt[j * 1024 + k] = w_in[(size_t)k * LDW_IN + NPROJ + j]; }
    __syncthreads();
    const int gw = F.vcu * NWAVES + F.wave, NGW = F.G * NWAVES;
    constexpr int I_IN = 16 * 72, I_OUT = 16 * 32, I_G = 16 * 88, I_D = 44 * 32, NITEMS = I_IN + I_OUT + 2 * I_G + I_D;
    for (int it = gw; it < NITEMS; it += NGW) {
        int r = it;
        if (r < I_IN) { p0_transpose_item(F.in[8], LDW_IN, 72, (const float*)nullptr, (bf16*)(F.ws + WS_WIN), 1024, RmId{}, scr, r, F.lane); continue; } r -= I_IN;
        if (r < I_OUT) { p0_transpose_item(F.in[16], 1024, 32, (const float*)nullptr, (bf16*)(F.ws + WS_WOUT), 1024, RmId{}, scr, r, F.lane); continue; } r -= I_OUT;
        if (r < I_G) { p0_transpose_item(F.in[18], DFF, 88, F.in[17], (bf16*)(F.ws + WS_WGU), 1024, RmGU{0}, scr, r, F.lane); continue; } r -= I_G;
        if (r < I_G) { p0_transpose_item(F.in[19], DFF, 88, F.in[17], (bf16*)(F.ws + WS_WGU), 1024, RmGU{1}, scr, r, F.lane); continue; } r -= I_G;
        p0_transpose_item(F.in[20], 1024, 32, (const float*)nullptr, (bf16*)(F.ws + WS_WD), DFF, RmId{}, scr, r, F.lane);
    }
    f32x4 w1[4];
#pragma unroll
    for (int j = 0; j < 4; ++j) w1[j] = ((const f32x4*)norm1)[64 * j + F.lane];
    for (int m = gw; m < MP; m += NGW) {
        GAS unsigned long long* o8 = (GAS unsigned long long*)(XN + (size_t)m * DM) + F.lane;
        if (m >= MREAL) {
#pragma unroll
            for (int j = 0; j < 4; ++j) o8[64 * j] = 0ull;
            continue; }
        const float* xrow = m < MPROMPT ? x_p + (size_t)m * DM : x_s + (size_t)(m - MPROMPT) * DM;
        const f32x4* xr = (const f32x4*)xrow + F.lane;
        f32x4 v[4]; float s = 0.f;
#pragma unroll
        for (int j = 0; j < 4; ++j) { v[j] = xr[64 * j]; s += (v[j][0] * v[j][0] + v[j][1] * v[j][1]) + (v[j][2] * v[j][2] + v[j][3] * v[j][3]); }
        const float rstd = 1.0f / sqrtf(wave_sum(s) * (1.0f / DM) + EPS);
        float d[8];
#pragma unroll
        for (int q = 0; q < 8; ++q) d[q] = 0.f;
#pragma unroll
        for (int j = 0; j < 4; ++j) { v[j] = v[j] * w1[j] * rstd;
#pragma unroll
            for (int q = 0; q < 8; ++q) { const f32x4 wq = *(const LAS f32x4*)(wdt + q * 1024 + 256 * j + 4 * F.lane); d[q] += (v[j][0] * wq[0] + v[j][1] * wq[1]) + (v[j][2] * wq[2] + v[j][3] * wq[3]); } }
#pragma unroll
        for (int q = 0; q < 8; ++q) d[q] = wave_sum(d[q]);
        float dsel = d[0];
#pragma unroll
        for (int q = 1; q < 8; ++q) dsel = (F.lane == q) ? d[q] : dsel;
        if (F.lane < 8) DT[(size_t)m * 8 + F.lane] = softplus_f(dsel + dt_bias[F.lane]);
#pragma unroll
        for (int j = 0; j < 4; ++j) o8[64 * j] = (unsigned long long)pk2(v[j][0], v[j][1]) | ((unsigned long long)pk2(v[j][2], v[j][3]) << 32);
    }
    const int gt = F.vcu * NWAVES * 64 + F.tid, NGT = F.G * NWAVES * 64;
    for (int i = gt; i < NB * 4064; i += NGT) { const int b = i / 4064, r = i % 4064;
        ((f32x4*)(F.out + O_KS + (size_t)b * 16384))[r] = ((const f32x4*)(F.in[2] + (size_t)b * 16384 + 128))[r];
        ((f32x4*)(F.out + O_VS + (size_t)b * 16384))[r] = ((const f32x4*)(F.in[3] + (size_t)b * 16384 + 128))[r]; }
    for (int i = gt; i < NB * 512; i += NGT) { const int b = i / 512, r = i % 512;
        ((f32x4*)(F.out + O_CS + (size_t)b * 3072))[r] = ((const f32x4*)(F.in[4] + (size_t)b * 3072 + 1024))[r]; }
}

__device__ __forceinline__ void p2_conv_naive(Frame& F) {
    const bf16* PROJ = (const bf16*)(F.ws + WS_PROJ); bf16* XC = (bf16*)(F.ws + WS_XC);
    const float* sconv = F.in[4]; const float* cw = F.in[10]; const float* cb = F.in[11];
    const int gt = F.vcu * NWAVES * 64 + F.tid, NGT = F.G * NWAVES * 64;
    for (int i = gt; i < MREAL * 256; i += NGT) { const int m = i >> 8, ch = (i & 255) * 4;
        float a[4];
#pragma unroll
        for (int e = 0; e < 4; ++e) a[e] = cb[ch + e];
#pragma unroll
        for (int j = 0; j < 4; ++j) { float xv[4] = {0.f, 0.f, 0.f, 0.f};
            if (m < MPROMPT) { const int t = m & (SEQ - 1); if (t - 3 + j >= 0) { const unsigned long long q = *(const unsigned long long*)(PROJ + (size_t)(m - 3 + j) * NPROJ + C_XBC + ch);
#pragma unroll
                    for (int e = 0; e < 4; ++e) xv[e] = bf2f((unsigned short)(q >> (16 * e))); } }
            else { const int b = m - MPROMPT;
                if (j < 3) { const f32x4 q = *(const f32x4*)(sconv + (size_t)b * 3072 + j * 1024 + ch);
#pragma unroll
                    for (int e = 0; e < 4; ++e) xv[e] = q[e]; }
                else { const unsigned long long q = *(const unsigned long long*)(PROJ + (size_t)m * NPROJ + C_XBC + ch);
#pragma unroll
                    for (int e = 0; e < 4; ++e) xv[e] = bf2f((unsigned short)(q >> (16 * e))); } }
#pragma unroll
            for (int e = 0; e < 4; ++e) a[e] += cw[j * 1024 + ch + e] * xv[e]; }
        *(unsigned long long*)(XC + (size_t)m * 1024 + ch) = (unsigned long long)pk2(silu_f(a[0]), silu_f(a[1])) | ((unsigned long long)pk2(silu_f(a[2]), silu_f(a[3])) << 32);
    }
    for (int i = gt; i < BATCH * 128 * 128; i += NGT) { const int c = i & 127, j = (i >> 7) & 127, b = i >> 14; const size_t row = (size_t)b * SEQ + (SEQ - 128) + j;
        F.out[O_KP + i] = bf2f(PROJ[row * NPROJ + C_K + c]); F.out[O_VP + i] = bf2f(PROJ[row * NPROJ + C_V + c]); }
    for (int i = gt; i < BATCH * 3 * 1024; i += NGT) { const int c = i & 1023, j = (i >> 10) % 3, b = i / 3072; F.out[O_CP + i] = bf2f(PROJ[((size_t)b * SEQ + SEQ - 3 + j) * NPROJ + C_XBC + c]); }
    for (int i = gt; i < NB * 128; i += NGT) { const int c = i & 127, b = i >> 7; const size_t row = MPROMPT + b;
        F.out[O_KS + (size_t)b * 16384 + 127 * 128 + c] = bf2f(PROJ[row * NPROJ + C_K + c]); F.out[O_VS + (size_t)b * 16384 + 127 * 128 + c] = bf2f(PROJ[row * NPROJ + C_V + c]); }
    for (int i = gt; i < NB * 1024; i += NGT) { const int c = i & 1023, b = i >> 10; F.out[O_CS + (size_t)b * 3072 + 2048 + c] = bf2f(PROJ[(size_t)(MPROMPT + b) * NPROJ + C_XBC + c]); }
}
__device__ __forceinline__ void p3_attn_naive(Frame& F) {
    const bf16* PROJ = (const bf16*)(F.ws + WS_PROJ); bf16* MIX = (bf16*)(F.ws + WS_MIX);
    const float* ck = F.in[2]; const float* cv = F.in[3]; const float* relb = F.in[6]; const float* sinks = F.in[9];
    const int gw = F.vcu * NWAVES + F.wave, NGW = F.G * NWAVES, lane = F.lane;
    for (int task = gw; task < MREAL * 8; task += NGW) { const int m = task >> 3, hh = task & 7, kvh = hh >> 2;
        const bool prompt = m < MPROMPT; const int t = m & (SEQ - 1), b = prompt ? (m >> 12) : (m - MPROMPT);
        float q[64];
        { const bf16* qp = PROJ + (size_t)m * NPROJ + C_Q + hh * 64;
#pragma unroll
          for (int d8 = 0; d8 < 8; ++d8) { const v4u w = *(const v4u*)(qp + d8 * 8);
#pragma unroll
              for (int e = 0; e < 4; ++e) { q[d8 * 8 + 2 * e] = __uint_as_float(w[e] << 16); q[d8 * 8 + 2 * e + 1] = __uint_as_float(w[e] & 0xffff0000u); } } }
        float s[2];
#pragma unroll
        for (int half = 0; half < 2; ++half) { const int i = lane + 64 * half; float acc = 0.f; bool valid = true;
            if (prompt) { const int kt = t - 127 + i; valid = kt >= 0;
                if (valid) { const bf16* kp = PROJ + (size_t)(m - 127 + i) * NPROJ + C_K + kvh * 64;
#pragma unroll
                    for (int d8 = 0; d8 < 8; ++d8) { const v4u w = *(const v4u*)(kp + d8 * 8);
#pragma unroll
                        for (int e = 0; e < 4; ++e) acc += q[d8 * 8 + 2 * e] * __uint_as_float(w[e] << 16) + q[d8 * 8 + 2 * e + 1] * __uint_as_float(w[e] & 0xffff0000u); } } }
            else if (i < 127) { const float* kp = ck + ((size_t)b * 128 + i + 1) * 128 + kvh * 64;
#pragma unroll
                for (int d4 = 0; d4 < 16; ++d4) { const f32x4 w = *(const f32x4*)(kp + d4 * 4); acc += (q[d4 * 4] * w[0] + q[d4 * 4 + 1] * w[1]) + (q[d4 * 4 + 2] * w[2] + q[d4 * 4 + 3] * w[3]); } }
            else { const bf16* kp = PROJ + (size_t)m * NPROJ + C_K + kvh * 64;
#pragma unroll
                for (int d8 = 0; d8 < 8; ++d8) { const v4u w = *(const v4u*)(kp + d8 * 8);
#pragma unroll
                    for (int e = 0; e < 4; ++e) acc += q[d8 * 8 + 2 * e] * __uint_as_float(w[e] << 16) + q[d8 * 8 + 2 * e + 1] * __uint_as_float(w[e] & 0xffff0000u); } }
            s[half] = valid ? acc * 0.125f + relb[BUCKET[127 - i] * 8 + hh] : -INFINITY; }
        const float sk = sinks[hh];
        const float mx = fmaxf(wave_max(fmaxf(s[0], s[1])), sk);
        float p0 = __expf(s[0] - mx), p1 = __expf(s[1] - mx);
        const float den = wave_sum(p0 + p1) + __expf(sk - mx), inv = 1.0f / den;
        p0 *= inv; p1 *= inv;
        float o = 0.f;
        for (int i = 0; i < 128; ++i) { const float p = __shfl(i < 64 ? p0 : p1, i & 63);
            float v = 0.f;
            if (prompt) { if (t - 127 + i >= 0) v = bf2f(PROJ[(size_t)(m - 127 + i) * NPROJ + C_V + kvh * 64 + lane]); }
            else if (i < 127) v = cv[((size_t)b * 128 + i + 1) * 128 + kvh * 64 + lane];
            else v = bf2f(PROJ[(size_t)m * NPROJ + C_V + kvh * 64 + lane]);
            o += p * v; }
        MIX[(size_t)m * 1024 + hh * 64 + lane] = (bf16)f2bf(o);
    }
}
__device__ __forceinline__ void p3_ssm_naive(Frame& F) {
    const bf16* XC = (const bf16*)(F.ws + WS_XC); const float* DT = (const float*)(F.ws + WS_DT); float* YS = (float*)(F.ws + WS_YS);
    const float* A_log = F.in[13]; const float* Dsk = F.in[14]; const float* st0 = F.in[5];
    const int gw = F.vcu * NWAVES + F.wave, NGW = F.G * NWAVES, lane = F.lane;
    for (int task = gw; task < BATCH * 8 * 64; task += NGW) { const int p = task & 63, hd = (task >> 6) & 7, b = task >> 9, g = hd >> 2;
        const float A = -expf(A_log[hd]), Dv = Dsk[hd]; float h0 = 0.f, h1 = 0.f;
        for (int t = 0; t < SEQ; ++t) { const size_t m = (size_t)b * SEQ + t;
            const float dt = DT[m * 8 + hd], x = bf2f(XC[m * 1024 + hd * 64 + p]);
            const unsigned bw = *(const unsigned*)(XC + m * 1024 + 512 + g * 128 + 2 * lane), cw = *(const unsigned*)(XC + m * 1024 + 768 + g * 128 + 2 * lane);
            const float dA = expf(dt * A), dx = dt * x;
            h0 = h0 * dA + dx * __uint_as_float(bw << 16); h1 = h1 * dA + dx * __uint_as_float(bw & 0xffff0000u);
            const float y = wave_sum(__uint_as_float(cw << 16) * h0 + __uint_as_float(cw & 0xffff0000u) * h1);
            if (lane == 0) YS[m * 512 + hd * 64 + p] = y + Dv * x; }
        F.out[O_SP + ((size_t)((b * 8 + hd) * 64 + p)) * 128 + 2 * lane] = h0; F.out[O_SP + ((size_t)((b * 8 + hd) * 64 + p)) * 128 + 2 * lane + 1] = h1;
    }
    for (int task = gw; task < NB * 8 * 64; task += NGW) { const int p = task & 63, hd = (task >> 6) & 7, b = task >> 9, g = hd >> 2; const size_t m = MPROMPT + b;
        const float A = -expf(A_log[hd]), Dv = Dsk[hd]; const size_t so = ((size_t)((b * 8 + hd) * 64 + p)) * 128 + 2 * lane;
        float h0 = st0[so], h1 = st0[so + 1];
        const float dt = DT[m * 8 + hd], x = bf2f(XC[m * 1024 + hd * 64 + p]);
        const unsigned bw = *(const unsigned*)(XC + m * 1024 + 512 + g * 128 + 2 * lane), cw = *(const unsigned*)(XC + m * 1024 + 768 + g * 128 + 2 * lane);
        const float dA = expf(dt * A), dx = dt * x;
        h0 = h0 * dA + dx * __uint_as_float(bw << 16); h1 = h1 * dA + dx * __uint_as_float(bw & 0xffff0000u);
        const float y = wave_sum(__uint_as_float(cw << 16) * h0 + __uint_as_float(cw & 0xffff0000u) * h1);
        if (lane == 0) YS[m * 512 + hd * 64 + p] = y + Dv * x;
        F.out[O_SS + so] = h0; F.out[O_SS + so + 1] = h1;
    }
}
__device__ __forceinline__ void p4_gate_naive(Frame& F) {
    const bf16* PROJ = (const bf16*)(F.ws + WS_PROJ); bf16* MIX = (bf16*)(F.ws + WS_MIX); const float* YS = (const float*)(F.ws + WS_YS); const float* nw = F.in[15];
    const int gw = F.vcu * NWAVES + F.wave, NGW = F.G * NWAVES, lane = F.lane;
    for (int task = gw; task < MREAL * 2; task += NGW) { const int m = task >> 1, ch = (task & 1) * 256 + 4 * lane;
        const f32x4 y = *(const f32x4*)(YS + (size_t)m * 512 + ch); const unsigned long long zq = *(const unsigned long long*)(PROJ + (size_t)m * NPROJ + C_Z + ch);
        float v[4]; float s = 0.f;
#pragma unroll
        for (int e = 0; e < 4; ++e) { v[e] = y[e] * silu_f(bf2f((unsigned short)(zq >> (16 * e)))); s += v[e] * v[e]; }
        const float rstd = 1.0f / sqrtf(wave_sum(s) * (1.0f / 256.0f) + EPS); const f32x4 w = *(const f32x4*)(nw + ch);
        *(unsigned long long*)(MIX + (size_t)m * 1024 + 512 + ch) = (unsigned long long)pk2(v[0] * rstd * w[0], v[1] * rstd * w[1]) | ((unsigned long long)pk2(v[2] * rstd * w[2], v[3] * rstd * w[3]) << 32);
    }
}
__device__ __forceinline__ void p8_final_norm(Frame& F) {
    const float* wf = F.in[21];
    const int gw = F.vcu * NWAVES + F.wave, NGW = F.G * NWAVES;
    f32x4 w[4];
#pragma unroll
    for (int j = 0; j < 4; ++j) w[j] = ((const f32x4*)wf)[64 * j + F.lane];
    for (int m = gw; m < MREAL; m += NGW) { f32x4* xr = (f32x4*)(F.out + (size_t)m * DM) + F.lane; f32x4 v[4]; float s = 0.f;
#pragma unroll
        for (int j = 0; j < 4; ++j) { v[j] = xr[64 * j]; s += (v[j][0] * v[j][0] + v[j][1] * v[j][1]) + (v[j][2] * v[j][2] + v[j][3] * v[j][3]); }
        const float rstd = 1.0f / sqrtf(wave_sum(s) * (1.0f / DM) + EPS);
#pragma unroll
        for (int j = 0; j < 4; ++j) xr[64 * j] = v[j] * rstd * w[j]; }
}

struct Args { const float* in[22]; float* out; unsigned char* ws; int ph_lo, ph_hi; };
constexpr int N_PHASES = 9;
#ifndef MK_ONE_LAUNCH
#define MK_ONE_LAUNCH 0
#endif
__global__ void __launch_bounds__(NWAVES * 64, 2) hymba_fwd(Args args) {
    extern __shared__ __attribute__((aligned(16))) unsigned char lds[];
    Frame F;
    F.lds = (LAS unsigned char*)lds;
    F.tid = threadIdx.x; F.lane = F.tid & 63; F.wave = __builtin_amdgcn_readfirstlane(F.tid >> 6);
    F.G = gridDim.x; { const int bx = blockIdx.x; F.vcu = (F.G % 8 == 0) ? (bx % 8) * (F.G / 8) + bx / 8 : bx; }
#pragma unroll
    for (int i = 0; i < 22; ++i) F.in[i] = args.in[i];
    F.out = args.out; F.ws = args.ws;
    volatile LAS unsigned* MISC = (volatile LAS unsigned*)(F.lds + MISC_OFF);
    if (F.tid < 64) MISC[F.tid] = 0u;
    __syncthreads();
    gu32* ctl = (gu32*)(F.ws + WS_CTL);
    XcdBarrier bar; bar.bar = (unsigned*)(ctl + CW_BAR); bar.x = 0; bar.st = nullptr;
    const int lo = args.ph_lo, hi = args.ph_hi;
    if (hi - lo > 1) bar = xcd_barrier_post((unsigned*)(ctl + CW_BAR), MISC + 8);
#define IN(k) (lo <= (k) && (k) < hi)
#define SEAM(k) do { if (IN(k) && IN((k) + 1)) xcd_barrier(bar); } while (0)
    bf16* XN = (bf16*)(F.ws + WS_XN); bf16* PROJ = (bf16*)(F.ws + WS_PROJ); bf16* MIX = (bf16*)(F.ws + WS_MIX); bf16* HB = (bf16*)(F.ws + WS_PROJ);
    float* SSQ1 = (float*)(F.ws + WS_SSQ1);
    if (IN(0)) { p0_prologue(F); SEAM(0); }
    if (IN(1)) {
        pg8::Gemm g{XN, (const bf16*)(F.ws + WS_WIN), MP, NPROJ, DM}; pg8::StaticOrder S; S.init(MP, NPROJ, F.G, (int)blockIdx.x);
        pg8::EpiStoreBf16 E{PROJ, NPROJ};
        pg8::gemm_phase<pg8::EpiStoreBf16, pg8::StaticOrder, true, true>(F.lds + RING_OFF, g, S, E);
        SEAM(1);
    }
    if (IN(2)) { p2_conv_naive(F); SEAM(2); }
    if (IN(3)) { p3_ssm_naive(F); p3_attn_naive(F); SEAM(3); }
    if (IN(4)) { p4_gate_naive(F); SEAM(4); }
    if (IN(5)) {
        pg8::Gemm g{MIX, (const bf16*)(F.ws + WS_WOUT), MP, DM, DM}; pg8::StaticOrder S; S.init(MP, DM, F.G, (int)blockIdx.x);
        pg8::EpiResid E{F.in[0], F.in[1], MPROMPT, F.out, XN, SSQ1, MREAL};
        pg8::gemm_phase<pg8::EpiResid, pg8::StaticOrder, true, true>(F.lds + RING_OFF, g, S, E);
        SEAM(5);
    }
    if (IN(6)) {
        pg8::Gemm g{XN, (const bf16*)(F.ws + WS_WGU), MP, NGU, DM}; pg8::StaticOrder S; S.init(MP, NGU, F.G, (int)blockIdx.x);
        pg8::EpiSwiglu E{HB, DFF, SSQ1, EPS};
        pg8::gemm_phase<pg8::EpiSwiglu, pg8::StaticOrder, true, true>(F.lds + RING_OFF, g, S, E);
        SEAM(6);
    }
    if (IN(7)) {
        pg8::Gemm g{HB, (const bf16*)(F.ws + WS_WD), MP, DM, DFF}; pg8::StaticOrder S; S.init(MP, DM, F.G, (int)blockIdx.x);
        pg8::EpiResid E{F.out, F.out, MP, F.out, nullptr, nullptr, MREAL};
        pg8::gemm_phase<pg8::EpiResid, pg8::StaticOrder, true, true>(F.lds + RING_OFF, g, S, E);
        SEAM(7);
    }
    if (IN(8)) { p8_final_norm(F); }
#undef IN
#undef SEAM
}

extern "C" void kernel_launch(void* const* d_in, const int* in_sizes, int n_in, void* d_out, int out_size, void* d_ws, size_t ws_size, hipStream_t stream) {
    static int grid = 0;
    if (grid == 0) {
        if (n_in != 22 || (size_t)out_size != O_END || ws_size < WS_END) { fprintf(stderr, "kernel_launch: unexpected shapes (n_in %d out %d ws %zu)\n", n_in, out_size, ws_size); grid = -1; return; }
        int dev = 0, cus = 0;
        if (hipGetDevice(&dev) != hipSuccess || hipDeviceGetAttribute(&cus, hipDeviceAttributeMultiprocessorCount, dev) != hipSuccess) { grid = -1; return; }
        if (hipFuncSetAttribute((const void*)hymba_fwd, hipFuncAttributeMaxDynamicSharedMemorySize, LDS_BYTES) != hipSuccess) { fprintf(stderr, "kernel_launch: hipFuncSetAttribute failed\n"); grid = -1; return; }
        int per_cu = 0;
        if (hipOccupancyMaxActiveBlocksPerMultiprocessor(&per_cu, (const void*)hymba_fwd, NWAVES * 64, LDS_BYTES) != hipSuccess || per_cu < 1) fprintf(stderr, "kernel_launch: occupancy query reports %d\n", per_cu);
        (void)hipGetLastError();
        grid = cus;
    }
    if (grid < 0) return;
    if (hipMemsetAsync((char*)d_ws + WS_CTL, 0, CTL_ZERO_BYTES, stream) != hipSuccess) return;
    Args a{};
    for (int i = 0; i < 22; ++i) a.in[i] = (const float*)d_in[i];
    a.out = (float*)d_out; a.ws = (unsigned char*)d_ws;
#if MK_ONE_LAUNCH
    a.ph_lo = 0; a.ph_hi = N_PHASES;
    hipLaunchKernelGGL(hymba_fwd, dim3(grid), dim3(NWAVES * 64), LDS_BYTES, stream, a);
#else
    for (int p = 0; p < N_PHASES; ++p) { a.ph_lo = p; a.ph_hi = p + 1; hipLaunchKernelGGL(hymba_fwd, dim3(grid), dim3(NWAVES * 64), LDS_BYTES, stream, a); }
#endif
}
```

```cpp
#include <hip/hip_runtime.h>
#include <cstdio>
#include <cstdint>
namespace pg8 {
#define PG8_LAS __attribute__((address_space(3)))
typedef unsigned short bf16_t;
typedef short bf16x8 __attribute__((ext_vector_type(8)));
typedef float f32x4 __attribute__((ext_vector_type(4)));
typedef unsigned u32x4 __attribute__((ext_vector_type(4)));
constexpr int BM = 256, BK = 64, HALF = 128, HTB = HALF * BK * 2  , STAGE_BYTES = 8 * HTB, NXCD = 8, WGM = 8;

__host__ __device__ __forceinline__ int lds_byte(int r, int c) { const int st = (r >> 4) * 2 + (c >> 5), rr = r & 15, cc = c & 31, ob = rr * 64 + cc * 2; return st * 1024 + (ob ^ (((ob >> 9) & 1) << 5)); }
__host__ __device__ __forceinline__ void stage_rc(int b, int& R, int& C) { const int st = b / 1024, sb = b % 1024, swz = sb ^ (((sb >> 9) & 1) << 5); R = (st >> 1) * 16 + swz / 64; C = (st & 1) * 32 + (swz % 64) / 2; }
__host__ __device__ __forceinline__ int perm32(int rho) { const int n = rho >> 4, i = rho & 15; return 8 * (i >> 2) + 4 * n + (i & 3); }

struct Unit { int pm, pn; };
struct Gemm { const bf16_t* A; const bf16_t* Bt; int M, N, K; };

struct StaticOrder {
    int nM, nN, nwg, G, c;
    __host__ __device__ void init(int M, int N, int G_, int c_) { nM = M / BM; nN = N / BM; nwg = nM * nN; G = G_; c = c_; }
    __host__ __device__ bool next(int i, Unit& u) const {
        const long L = (long)i * G + c; if (L >= nwg) return false;
        int wgid = (int)L; { const int q = nwg / NXCD, r = nwg % NXCD, xcd = wgid % NXCD, off = wgid / NXCD; wgid = (xcd < r ? xcd * (q + 1) : r * (q + 1) + (xcd - r) * q) + off; }
        const int nig = WGM * nN, gid = wgid / nig, fm = gid * WGM, gsz = (nM - fm) < WGM ? (nM - fm) : WGM;
        u.pm = fm + ((wgid % nig) % gsz); u.pn = (wgid % nig) / gsz; return true;
    }
    __device__ __forceinline__ void a_ready(const Unit&) const {}
    __device__ __forceinline__ void done(const Unit&) const {}
};

__device__ __forceinline__ unsigned cvt_pk_bf16(float lo, float hi) { unsigned r; asm volatile("v_cvt_pk_bf16_f32 %0, %1, %2" : "=v"(r) : "v"(lo), "v"(hi)); return r; }
typedef unsigned u32x2 __attribute__((ext_vector_type(2)));
struct EpiStoreBf16 {
    static constexpr bool PERM = true, AFTER_DRAIN = false;
    bf16_t* O; int ldc;
    __device__ __forceinline__ void operator()(const f32x4 (&acc)[2][2][4][2], const Unit& u, int wr, int wc, int fr, int fq) const {
        const int row0 = u.pm * BM + wr * 64 + fr, col0 = u.pn * BM + wc * 32 + 8 * fq;
#pragma unroll
        for (int ai = 0; ai < 2; ++ai)
#pragma unroll
            for (int m = 0; m < 4; ++m) { bf16_t* rowp = O + (size_t)(row0 + ai * HALF + m * 16) * ldc + col0;
#pragma unroll
                for (int bj = 0; bj < 2; ++bj) { const f32x4 v0 = acc[ai][bj][m][0], v1 = acc[ai][bj][m][1];
                    u32x4 w; w.x = cvt_pk_bf16(v0[0], v0[1]); w.y = cvt_pk_bf16(v0[2], v0[3]); w.z = cvt_pk_bf16(v1[0], v1[1]); w.w = cvt_pk_bf16(v1[2], v1[3]);
                    *(u32x4*)(rowp + bj * HALF) = w; } }
    }
};
struct EpiResid {
    static constexpr bool PERM = false, AFTER_DRAIN = false;
    const float* base0; const float* base1; int split; float* out; bf16_t* xb; float* ssq; int mreal;
    __device__ __forceinline__ void operator()(const f32x4 (&acc)[2][2][4][2], const Unit& u, int wr, int wc, int fr, int fq) const {
        const int col0 = u.pn * BM + wc * 32 + 4 * fq;
#pragma unroll
        for (int ai = 0; ai < 2; ++ai)
#pragma unroll
            for (int m = 0; m < 4; ++m) { const int row = u.pm * BM + ai * HALF + wr * 64 + m * 16 + fr;
                float s = 0.f;
                if (row < mreal) {
                    const float* bp = (row < split ? base0 + (size_t)row * 1024 : base1 + (size_t)(row - split) * 1024) + col0;
                    float* op = out + (size_t)row * 1024 + col0;
#pragma unroll
                    for (int bj = 0; bj < 2; ++bj)
#pragma unroll
                        for (int n = 0; n < 2; ++n) { const f32x4 v = *(const f32x4*)(bp + bj * HALF + n * 16) + acc[ai][bj][m][n];
                            *(f32x4*)(op + bj * HALF + n * 16) = v; s += (v[0] * v[0] + v[1] * v[1]) + (v[2] * v[2] + v[3] * v[3]);
                            if (xb) { u32x2 w; w.x = cvt_pk_bf16(v[0], v[1]); w.y = cvt_pk_bf16(v[2], v[3]); *(u32x2*)(xb + (size_t)row * 1024 + col0 + bj * HALF + n * 16) = w; } }
                }
                if (ssq) { s += __shfl_xor(s, 16); s += __shfl_xor(s, 32); if (fq == 0 && row < mreal) ssq[(size_t)row * 16 + u.pn * 4 + wc] = s; }
            }
    }
};
struct EpiSwiglu {
    static constexpr bool PERM = true, AFTER_DRAIN = false;
    bf16_t* H; int ldh; const float* ssq; float eps;
    __device__ __forceinline__ void operator()(const f32x4 (&acc)[2][2][4][2], const Unit& u, int wr, int wc, int fr, int fq) const {
        const int row0 = u.pm * BM + wr * 64 + fr, hcol0 = (u.pn * BM + wc * 32 + 8 * fq) >> 1;
#pragma unroll
        for (int ai = 0; ai < 2; ++ai)
#pragma unroll
            for (int m = 0; m < 4; ++m) { const int row = row0 + ai * HALF + m * 16;
                const f32x4* sp = (const f32x4*)(ssq + (size_t)row * 16); const f32x4 s0 = sp[0], s1 = sp[1], s2 = sp[2], s3 = sp[3];
                const float sum = ((s0[0] + s0[1]) + (s0[2] + s0[3])) + ((s1[0] + s1[1]) + (s1[2] + s1[3])) + ((s2[0] + s2[1]) + (s2[2] + s2[3])) + ((s3[0] + s3[1]) + (s3[2] + s3[3]));
                const float rstd = 1.0f / sqrtf(sum * (1.0f / 1024.0f) + eps);
#pragma unroll
                for (int bj = 0; bj < 2; ++bj) { const f32x4 g = acc[ai][bj][m][0] * rstd, up = acc[ai][bj][m][1] * rstd; float hv[4];
#pragma unroll
                    for (int e = 0; e < 4; ++e) hv[e] = g[e] * __builtin_amdgcn_rcpf(1.0f + __expf(-g[e])) * up[e];
                    u32x2 w; w.x = cvt_pk_bf16(hv[0], hv[1]); w.y = cvt_pk_bf16(hv[2], hv[3]);
                    *(u32x2*)(H + (size_t)row * ldh + hcol0 + bj * (HALF / 2)) = w; } }
    }
};
template <class Epi, class Sched, bool ALIGN_EPI = false, bool SP2 = false>
__device__ __forceinline__ void gemm_phase(PG8_LAS unsigned char* lds, const Gemm g, const Sched& S, const Epi& E) {
    const int tid = threadIdx.x, wid = __builtin_amdgcn_readfirstlane(tid >> 6), lane = tid & 63, wr = wid >> 2, wc = wid & 3, fr = lane & 15, fq = lane >> 4;
    const int K = g.K, nt = K / BK;
    unsigned voffA[2], voffB[2];
#pragma unroll
    for (int i = 0; i < 2; ++i) { int R, C; stage_rc(tid * 16 + i * 8192, R, C); const int Rb = Epi::PERM ? ((R & ~31) + perm32(R & 31)) : R;
        voffA[i] = (unsigned)(R * K + C) * 2u; voffB[i] = (unsigned)(Rb * K + C) * 2u; }
    const size_t kstep = (size_t)(BK * 2);
    const size_t hstep = (size_t)HALF * K * 2;
    const size_t tstep = 2 * hstep;
    const unsigned ldsw = (unsigned)wid * 1024u;
    const int aoff = lds_byte(wr * 64 + fr, fq * 8), boff = lds_byte(wc * 32 + fr, fq * 8);
#define PG8_SA(b, h) (((b) * 2 + (h)) * HTB)
#define PG8_SB(b, h) ((4 + (b) * 2 + (h)) * HTB)
#define PG8_STAGE(bufoff, gbase, voff) do { _Pragma("unroll") for (int _i = 0; _i < 2; ++_i) \
        __builtin_amdgcn_global_load_lds((const unsigned*)((const char*)(gbase) + (voff)[_i]), (PG8_LAS unsigned*)(lds + (bufoff) + ldsw + _i * 8192), 16, 0, 0); } while (0)
#define PG8_LDA(dst, b, h) do { _Pragma("unroll") for (int m = 0; m < 4; ++m) _Pragma("unroll") for (int k = 0; k < 2; ++k) dst[m][k] = *(const PG8_LAS bf16x8*)(lds + PG8_SA(b, h) + aoff + m * 2048 + k * 1024); } while (0)
#define PG8_LDB(dst, b, h) do { _Pragma("unroll") for (int n = 0; n < 2; ++n) _Pragma("unroll") for (int k = 0; k < 2; ++k) dst[n][k] = *(const PG8_LAS bf16x8*)(lds + PG8_SB(b, h) + boff + n * 2048 + k * 1024); } while (0)
#define PG8_MMA(ai, bj, At, Bt) do { __builtin_amdgcn_s_setprio(1); _Pragma("unroll") for (int m = 0; m < 4; ++m) _Pragma("unroll") for (int n = 0; n < 2; ++n) _Pragma("unroll") for (int k = 0; k < 2; ++k) \
        acc[ai][bj][m][n] = __builtin_amdgcn_mfma_f32_16x16x32_bf16(Bt[n][k], At[m][k], acc[ai][bj][m][n], 0, 0, 0); __builtin_amdgcn_s_setprio(0); } while (0)
#define PG8_WAIT_V(n) asm volatile("s_waitcnt vmcnt(" #n ")" ::: "memory")
#define PG8_WAIT_L(n) asm volatile("s_waitcnt lgkmcnt(" #n ")" ::: "memory")
#define PG8_BAR __builtin_amdgcn_s_barrier()
#define PG8_SCHED __builtin_amdgcn_sched_barrier(0)
    Unit cur, nxt; int ui = 0;
    if (!S.next(0, cur)) return;
    f32x4 acc[2][2][4][2];
#pragma unroll
    for (int a = 0; a < 2; ++a)
#pragma unroll
        for (int b = 0; b < 2; ++b)
#pragma unroll
            for (int m = 0; m < 4; ++m)
#pragma unroll
                for (int n = 0; n < 2; ++n) acc[a][b][m][n] = (f32x4){0.f, 0.f, 0.f, 0.f};
    bf16x8 At[4][2], B0[2][2], B1[2][2];
    const char* cA = (const char*)g.A + (size_t)cur.pm * tstep; const char* cB = (const char*)g.Bt + (size_t)cur.pn * tstep;
    S.a_ready(cur);
    if constexpr (SP2) {
        PG8_STAGE(PG8_SB(0, 0), cB, voffB); PG8_STAGE(PG8_SB(0, 1), cB + hstep, voffB); PG8_STAGE(PG8_SA(0, 0), cA, voffA); PG8_STAGE(PG8_SA(0, 1), cA + hstep, voffA);
        if (wr == 1) PG8_BAR;
        PG8_WAIT_V(2); PG8_BAR;
        PG8_STAGE(PG8_SB(1, 0), cB + kstep, voffB); PG8_STAGE(PG8_SA(1, 0), cA + kstep, voffA); PG8_STAGE(PG8_SB(1, 1), cB + hstep + kstep, voffB);
        PG8_WAIT_V(6); PG8_BAR;
    } else {
        PG8_STAGE(PG8_SB(0, 0), cB, voffB); PG8_STAGE(PG8_SA(0, 0), cA, voffA); PG8_STAGE(PG8_SB(0, 1), cB + hstep, voffB); PG8_STAGE(PG8_SA(0, 1), cA + hstep, voffA);
        if (wr == 1) PG8_BAR;
        PG8_WAIT_V(4); PG8_BAR;
        PG8_STAGE(PG8_SB(1, 0), cB + kstep, voffB); PG8_STAGE(PG8_SA(1, 0), cA + kstep, voffA); PG8_STAGE(PG8_SB(1, 1), cB + hstep + kstep, voffB);
        PG8_WAIT_V(6); PG8_BAR;
    }
    for (;;) {
        const bool has_next = S.next(ui + 1, nxt);
        const char* nA = has_next ? (const char*)g.A + (size_t)nxt.pm * tstep : cA; const char* nB = has_next ? (const char*)g.Bt + (size_t)nxt.pn * tstep : cB;
        for (int t = 0; t < nt; t += 2) {
            const bool last = (t == nt - 2);
            const char* a1 = cA + (size_t)(t + 1) * kstep;
            const char* a2 = last ? nA : cA + (size_t)(t + 2) * kstep; const char* b2 = last ? nB : cB + (size_t)(t + 2) * kstep;
            const char* a3 = a2 + kstep; const char* b3 = b2 + kstep;
            if (last && has_next) S.a_ready(nxt);
            if constexpr (SP2) {
            PG8_LDB(B0, 0, 0); PG8_LDB(B1, 0, 1); PG8_SCHED; PG8_LDA(At, 0, 0); PG8_STAGE(PG8_SA(1, 1), a1 + hstep, voffA);
            PG8_WAIT_V(8); PG8_WAIT_L(0); PG8_BAR; PG8_MMA(0, 0, At, B0); PG8_MMA(0, 1, At, B1); PG8_BAR; PG8_SCHED;
            PG8_LDA(At, 0, 1); PG8_STAGE(PG8_SB(0, 0), b2, voffB); PG8_STAGE(PG8_SB(0, 1), b2 + hstep, voffB); PG8_STAGE(PG8_SA(0, 0), a2, voffA);
            PG8_WAIT_V(8); PG8_WAIT_L(0); PG8_BAR; PG8_MMA(1, 0, At, B0); PG8_MMA(1, 1, At, B1); PG8_BAR; PG8_SCHED;
            PG8_LDB(B0, 1, 0); PG8_LDB(B1, 1, 1); PG8_SCHED; PG8_LDA(At, 1, 0); PG8_STAGE(PG8_SA(0, 1), a2 + hstep, voffA);
            PG8_WAIT_V(8); PG8_WAIT_L(0); PG8_BAR; PG8_MMA(0, 0, At, B0); PG8_MMA(0, 1, At, B1); PG8_BAR; PG8_SCHED;
            PG8_LDA(At, 1, 1); PG8_STAGE(PG8_SB(1, 0), b3, voffB); PG8_STAGE(PG8_SB(1, 1), b3 + hstep, voffB); PG8_STAGE(PG8_SA(1, 0), a3, voffA);
            PG8_WAIT_V(8); PG8_WAIT_L(0); PG8_BAR; PG8_MMA(1, 0, At, B0); PG8_MMA(1, 1, At, B1); PG8_BAR; PG8_SCHED;
            } else {
            PG8_LDB(B0, 0, 0); PG8_SCHED; PG8_LDA(At, 0, 0); PG8_STAGE(PG8_SA(1, 1), a1 + hstep, voffA);
            PG8_WAIT_L(8); PG8_BAR; PG8_WAIT_L(0); PG8_MMA(0, 0, At, B0); PG8_BAR; PG8_SCHED;
            PG8_LDB(B1, 0, 1); PG8_STAGE(PG8_SB(0, 0), b2, voffB);
            PG8_BAR; PG8_WAIT_L(0); PG8_MMA(0, 1, At, B1); PG8_BAR;
            PG8_LDA(At, 0, 1); PG8_STAGE(PG8_SA(0, 0), a2, voffA);
            PG8_BAR; PG8_WAIT_L(0); PG8_MMA(1, 0, At, B0); PG8_BAR; PG8_SCHED;
            PG8_STAGE(PG8_SB(0, 1), b2 + hstep, voffB);
            PG8_WAIT_V(6); PG8_BAR; PG8_MMA(1, 1, At, B1); PG8_BAR;
            PG8_LDB(B0, 1, 0); PG8_SCHED; PG8_LDA(At, 1, 0); PG8_STAGE(PG8_SA(0, 1), a2 + hstep, voffA);
            PG8_WAIT_L(8); PG8_BAR; PG8_WAIT_L(0); PG8_MMA(0, 0, At, B0); PG8_BAR; PG8_SCHED;
            PG8_LDB(B1, 1, 1); PG8_STAGE(PG8_SB(1, 0), b3, voffB);
            PG8_BAR; PG8_WAIT_L(0); PG8_MMA(0, 1, At, B1); PG8_BAR;
            PG8_LDA(At, 1, 1); PG8_STAGE(PG8_SA(1, 0), a3, voffA);
            PG8_BAR; PG8_WAIT_L(0); PG8_MMA(1, 0, At, B0); PG8_BAR; PG8_SCHED;
            PG8_STAGE(PG8_SB(1, 1), b3 + hstep, voffB);
            PG8_WAIT_V(6); PG8_BAR; PG8_MMA(1, 1, At, B1); PG8_BAR;
            }
        }
        if constexpr (ALIGN_EPI) { if (wr == 0) PG8_BAR; }
        if constexpr (!Epi::AFTER_DRAIN) { E(acc, cur, wr, wc, fr, fq); S.done(cur); }
        if (!has_next) break;
#pragma unroll
        for (int a = 0; a < 2; ++a)
#pragma unroll
            for (int b = 0; b < 2; ++b)
#pragma unroll
                for (int m = 0; m < 4; ++m)
#pragma unroll
                    for (int n = 0; n < 2; ++n) acc[a][b][m][n] = (f32x4){0.f, 0.f, 0.f, 0.f};
        cur = nxt; cA = nA; cB = nB; ++ui;
        if constexpr (ALIGN_EPI) { if (wr == 1) PG8_BAR; }
    }
    PG8_WAIT_V(0);
    if constexpr (!ALIGN_EPI) { if (wr == 0) PG8_BAR; }
    PG8_BAR;
    if constexpr (Epi::AFTER_DRAIN) { E.fused(acc, cur, wr, wc, fr, fq, lds, wid, lane); S.done(cur); }
#undef PG8_SA
#undef PG8_SB
#undef PG8_STAGE
#undef PG8_LDA
#undef PG8_LDB
#undef PG8_MMA
#undef PG8_WAIT_V
#undef PG8_WAIT_L
#undef PG8_BAR
#undef PG8_SCHED
}
}
#define GAS __attribute__((address_space(1)))
#define LAS __attribute__((address_space(3)))
typedef unsigned short bf16;
typedef unsigned v4u __attribute__((ext_vector_type(4)));
typedef float f32x4 __attribute__((ext_vector_type(4)));
typedef short bf16x8 __attribute__((ext_vector_type(8)));
typedef GAS unsigned gu32;
typedef GAS unsigned long long gu64;
#define RLX_AGENT __ATOMIC_RELAXED, __HIP_MEMORY_SCOPE_AGENT
#define LDS_WAIT() asm volatile("s_waitcnt lgkmcnt(0)" ::: "memory")
#define VM_WAIT() asm volatile("s_waitcnt vmcnt(0)" ::: "memory")
__device__ __forceinline__ unsigned long long rt() { return __builtin_amdgcn_s_memrealtime(); }
__device__ __forceinline__ unsigned f2bf(float f) { unsigned u = __builtin_bit_cast(unsigned, f); return (u + 0x7fffu + ((u >> 16) & 1u)) >> 16; }
__device__ __forceinline__ unsigned pk2(float lo, float hi) { return f2bf(lo) | (f2bf(hi) << 16); }

#define XB_TMO      128
#define XB_XCNT(j)  (256  + 64 * (j))
#define XB_XSUB(j)  (1280 + 64 * (j))
#define XB_XGEN(j)  (2304 + 64 * (j))
#define XB_TOP      3328
#define XB_TOPGEN   3392
#define XCD_BAR_WORDS 3456
#define XB_SPIN_CAP (1u << 18)

__device__ __forceinline__ unsigned xb_ld(unsigned* p)              { return __hip_atomic_load(p, __ATOMIC_RELAXED, __HIP_MEMORY_SCOPE_AGENT); }
__device__ __forceinline__ unsigned xb_add(unsigned* p, unsigned v) { return __hip_atomic_fetch_add(p, v, __ATOMIC_RELAXED, __HIP_MEMORY_SCOPE_AGENT); }
__device__ __forceinline__ unsigned xb_xcc_id() { return (unsigned)__builtin_amdgcn_s_getreg((3 << 11) | 20) & 0xFu; }
#define XB_SPIN(cond, bar) do { unsigned _sp = 0; while (cond) { __builtin_amdgcn_s_sleep(1); \
    if ((++_sp & 255u) == 0u) { if (xb_ld(&(bar)[XB_TMO])) break; if (_sp > XB_SPIN_CAP) { atomicAdd(&(bar)[XB_TMO], 1u); break; } } } } while (0)

struct XcdBarrier {
    unsigned* bar; unsigned x;
    volatile LAS unsigned* st;
};

__device__ __forceinline__ XcdBarrier xcd_barrier_post(unsigned* bar, volatile LAS unsigned* st) {
    XcdBarrier b; b.bar = bar; b.x = xb_xcc_id(); b.st = st;
    if (threadIdx.x == 0) (void)xb_add(&bar[XB_XCNT(b.x)], 1u);
    return b;
}
__device__ __forceinline__ void xcd_barrier_complete(unsigned* bar, unsigned x, unsigned& nloc, unsigned& nx) {
    const unsigned G = gridDim.x * gridDim.y * gridDim.z;
    unsigned sum, cnt, mine, sp = 0u;
    for (;;) {
        sum = 0u; cnt = 0u; mine = 0u;
#pragma unroll
        for (unsigned j = 0; j < 16; ++j) { const unsigned c = xb_ld(&bar[XB_XCNT(j)]); sum += c; cnt += (c > 0u) ? 1u : 0u; mine = (j == x) ? c : mine; }
        if (sum == G) break;
        __builtin_amdgcn_s_sleep(1);
        if ((++sp & 255u) == 0u) { if (xb_ld(&bar[XB_TMO])) break; if (sp > XB_SPIN_CAP) { atomicAdd(&bar[XB_TMO], 1u); break; } }
    }
    nloc = mine > 0u ? mine : 1u; nx = cnt > 0u ? cnt : 1u;
}

__device__ __forceinline__ void xcd_barrier(const XcdBarrier& b) {
    asm volatile("s_waitcnt vmcnt(0)" ::: "memory");
    __syncthreads();
    if (threadIdx.x == 0) {
        unsigned* bar = b.bar;
        __builtin_amdgcn_s_waitcnt(0);
        unsigned nloc = b.st[0], nx = b.st[1];
        if (nloc == 0u) { xcd_barrier_complete(bar, b.x, nloc, nx); b.st[0] = nloc; b.st[1] = nx; }
        const unsigned old = xb_add(&bar[XB_XSUB(b.x)], 1u);
        const unsigned gen = old / nloc;
        if (old + 1u == (gen + 1u) * nloc) {
            __builtin_amdgcn_fence(__ATOMIC_RELEASE, "agent");
            asm volatile("s_waitcnt vmcnt(0)" ::: "memory");
            const unsigned og = xb_add(&bar[XB_TOP], 1u);
            const unsigned tg = og / nx;
            if (og + 1u == (tg + 1u) * nx) xb_add(&bar[XB_TOPGEN], 1u);
            else XB_SPIN(xb_ld(&bar[XB_TOPGEN]) == tg, bar);
            __builtin_amdgcn_fence(__ATOMIC_ACQUIRE, "agent");
            xb_add(&bar[XB_XGEN(b.x)], 1u);
            asm volatile("s_waitcnt vmcnt(0)" ::: "memory");
        } else {
            XB_SPIN(xb_ld(&bar[XB_XGEN(b.x)]) == gen, bar);
            __builtin_amdgcn_fence(__ATOMIC_ACQUIRE, "agent");
            asm volatile("s_waitcnt vmcnt(0)" ::: "memory");
        }
    }
    __syncthreads();
}
constexpr int NWAVES = 8;
constexpr int DM = 1024, BATCH = 4, SEQ = 4096, NB = 128  , MPROMPT = BATCH * SEQ, MREAL = MPROMPT + NB, MP = 16640  ;
constexpr int NPROJ = 2304, LDW_IN = 2312, DFF = 2816, NGU = 2 * DFF;
constexpr int C_Q = 0, C_K = 512, C_V = 640, C_Z = 768, C_XBC = 1280, C_B = 1792, C_C = 2048;
constexpr float EPS = 1e-6f;
constexpr size_t O_YP = 0, O_YS = 16777216, O_KP = 16908288, O_VP = 16973824, O_CP = 17039360, O_SP = 17051648, O_KS = 17313792, O_VS = 19410944, O_CS = 21508096, O_SS = 21901312, O_END = 30289920;
constexpr size_t MiB = 1u << 20;
constexpr size_t WS_CTL = 0, CTL_ZERO_BYTES = 1 * MiB;
constexpr size_t WS_WIN = 2 * MiB;
constexpr size_t WS_WOUT = 7 * MiB;
constexpr size_t WS_WGU = 9 * MiB;
constexpr size_t WS_WD = 20 * MiB;
constexpr size_t WS_DT = 26 * MiB;
constexpr size_t WS_SSQ1 = 27 * MiB;
constexpr size_t WS_XN = 32 * MiB;
constexpr size_t WS_PROJ = 66 * MiB;
constexpr size_t WS_MIX = 140 * MiB;
constexpr size_t WS_YS = 174 * MiB;
constexpr size_t WS_XC = 208 * MiB;
constexpr size_t WS_END = 256 * MiB;
static_assert(WS_PROJ + (size_t)MP * DFF * 2 <= WS_YS && WS_XC + (size_t)MP * 1024 * 2 <= WS_END, "ws map");
constexpr int CW_BAR = 4096;

constexpr int RING_OFF = 0, RING_BYTES = 131072;
constexpr int LDS_BYTES = 163840;
constexpr int MISC_OFF = LDS_BYTES - 256;

__device__ const unsigned char BUCKET[128] = {0, 1, 2, 3, 4, 5, 6, 7, 8, 9, 10, 11, 12, 13, 14, 15, 16, 16, 16, 17, 17, 18, 18, 18, 19, 19, 19, 20, 20, 20, 20, 21, 21, 21, 21, 22, 22, 22, 22, 22, 23, 23, 23, 23, 23, 23, 24, 24, 24, 24, 24, 24, 25, 25, 25, 25, 25, 25, 25, 26, 26, 26, 26, 26, 26, 26, 26, 27, 27, 27, 27, 27, 27, 27, 27, 27, 27, 28, 28, 28, 28, 28, 28, 28, 28, 28, 28, 29, 29, 29, 29, 29, 29, 29, 29, 29, 29, 29, 29, 30, 30, 30, 30, 30, 30, 30, 30, 30, 30, 30, 30, 30, 30, 31, 31, 31, 31, 31, 31, 31, 31, 31, 31, 31, 31, 31, 31, 31};

__device__ __forceinline__ float bf2f(unsigned short b) { return __uint_as_float((unsigned)b << 16); }
__device__ __forceinline__ float wave_sum(float v) {
#pragma unroll
    for (int o = 1; o < 64; o <<= 1) v += __shfl_xor(v, o);
    return v;
}
__device__ __forceinline__ float wave_max(float v) {
#pragma unroll
    for (int o = 1; o < 64; o <<= 1) v = fmaxf(v, __shfl_xor(v, o));
    return v;
}
__device__ __forceinline__ float silu_f(float a) { return a / (1.0f + __expf(-a)); }
__device__ __forceinline__ float softplus_f(float v) { return fmaxf(v, 0.f) + log1pf(expf(-fabsf(v))); }

struct Frame {
    LAS unsigned char* lds;
    int tid, lane, wave, G, vcu;
    const float* in[22]; float* out; unsigned char* ws;
};

template <class RowMap>
__device__ __forceinline__ void p0_transpose_item(const float* W, int ldw, int nblk, const float* kscale, bf16* WT, int ldo, RowMap rm, LAS float* scr, int item, int lane) {
    const int kb = item / nblk, nb = item % nblk, k0 = 64 * kb, n0 = 32 * nb;
#pragma unroll 8
    for (int i = 0; i < 32; ++i) { const int kk = 2 * i + (lane >> 5); float v = W[(size_t)(k0 + kk) * ldw + n0 + (lane & 31)]; if (kscale) v *= kscale[k0 + kk]; scr[kk * 33 + (lane & 31)] = v; }
    LDS_WAIT(); asm volatile("" ::: "memory");
    const int c = lane & 7;
#pragma unroll
    for (int j = 0; j < 4; ++j) { const int n = (lane >> 3) + 8 * j; const LAS float* s = scr + (8 * c) * 33 + n;
        v4u o; o.x = pk2(s[0 * 33], s[1 * 33]); o.y = pk2(s[2 * 33], s[3 * 33]); o.z = pk2(s[4 * 33], s[5 * 33]); o.w = pk2(s[6 * 33], s[7 * 33]);
        *(GAS v4u*)(WT + (size_t)rm(n0 + n) * ldo + k0 + 8 * c) = o; }
    LDS_WAIT(); asm volatile("" ::: "memory");
}
struct RmId { __device__ __forceinline__ int operator()(int n) const { return n; } };
struct RmGU { int up; __device__ __forceinline__ int operator()(int n) const { return 8 * (n >> 2) + (n & 3) + 4 * up; } };

__device__ __forceinline__ void p0_prologue(Frame& F) {
    const float* x_p = F.in[0]; const float* x_s = F.in[1]; const float* norm1 = F.in[7]; const float* w_in = F.in[8]; const float* dt_bias = F.in[12];
    bf16* XN = (bf16*)(F.ws + WS_XN); float* DT = (float*)(F.ws + WS_DT);
    LAS float* wdt = (LAS float*)(F.lds);
    LAS float* scr = (LAS float*)(F.lds + 32768 + F.wave * 12288);
    for (int i = F.tid; i < 8192; i += NWAVES * 64) { const int k = i >> 3, j = i & 7; wdt[j * 1024 + k] = w_in[(size_t)k * LDW_IN + NPROJ + j]; }
    __syncthreads();
    const int gw = F.vcu * NWAVES + F.wave, NGW = F.G * NWAVES;
    constexpr int I_IN = 16 * 72, I_OUT = 16 * 32, I_G = 16 * 88, I_D = 44 * 32, NITEMS = I_IN + I_OUT + 2 * I_G + I_D;
    for (int it = gw; it < NITEMS; it += NGW) {
        int r = it;
        if (r < I_IN) { p0_transpose_item(F.in[8], LDW_IN, 72, (const float*)nullptr, (bf16*)(F.ws + WS_WIN), 1024, RmId{}, scr, r, F.lane); continue; } r -= I_IN;
        if (r < I_OUT) { p0_transpose_item(F.in[16], 1024, 32, (const float*)nullptr, (bf16*)(F.ws + WS_WOUT), 1024, RmId{}, scr, r, F.lane); continue; } r -= I_OUT;
        if (r < I_G) { p0_transpose_item(F.in[18], DFF, 88, F.in[17], (bf16*)(F.ws + WS_WGU), 1024, RmGU{0}, scr, r, F.lane); continue; } r -= I_G;
        if (r < I_G) { p0_transpose_item(F.in[19], DFF, 88, F.in[17], (bf16*)(F.ws + WS_WGU), 1024, RmGU{1}, scr, r, F.lane); continue; } r -= I_G;
        p0_transpose_item(F.in[20], 1024, 32, (const float*)nullptr, (bf16*)(F.ws + WS_WD), DFF, RmId{}, scr, r, F.lane);
    }
    f32x4 w1[4];
#pragma unroll
    for (int j = 0; j < 4; ++j) w1[j] = ((const f32x4*)norm1)[64 * j + F.lane];
    for (int m = gw; m < MP; m += NGW) {
        GAS unsigned long long* o8 = (GAS unsigned long long*)(XN + (size_t)m * DM) + F.lane;
        if (m >= MREAL) {
#pragma unroll
            for (int j = 0; j < 4; ++j) o8[64 * j] = 0ull;
            continue; }
        const float* xrow = m < MPROMPT ? x_p + (size_t)m * DM : x_s + (size_t)(m - MPROMPT) * DM;
        const f32x4* xr = (const f32x4*)xrow + F.lane;
        f32x4 v[4]; float s = 0.f;
#pragma unroll
        for (int j = 0; j < 4; ++j) { v[j] = xr[64 * j]; s += (v[j][0] * v[j][0] + v[j][1] * v[j][1]) + (v[j][2] * v[j][2] + v[j][3] * v[j][3]); }
        const float rstd = 1.0f / sqrtf(wave_sum(s) * (1.0f / DM) + EPS);
        float d[8];
#pragma unroll
        for (int q = 0; q < 8; ++q) d[q] = 0.f;
#pragma unroll
        for (int j = 0; j < 4; ++j) { v[j] = v[j] * w1[j] * rstd;
#pragma unroll
            for (int q = 0; q < 8; ++q) { const f32x4 wq = *(const LAS f32x4*)(wdt + q * 1024 + 256 * j + 4 * F.lane); d[q] += (v[j][0] * wq[0] + v[j][1] * wq[1]) + (v[j][2] * wq[2] + v[j][3] * wq[3]); } }
#pragma unroll
        for (int q = 0; q < 8; ++q) d[q] = wave_sum(d[q]);
        float dsel = d[0];
#pragma unroll
        for (int q = 1; q < 8; ++q) dsel = (F.lane == q) ? d[q] : dsel;
        if (F.lane < 8) DT[(size_t)m * 8 + F.lane] = softplus_f(dsel + dt_bias[F.lane]);
#pragma unroll
        for (int j = 0; j < 4; ++j) o8[64 * j] = (unsigned long long)pk2(v[j][0], v[j][1]) | ((unsigned long long)pk2(v[j][2], v[j][3]) << 32);
    }
    const int gt = F.vcu * NWAVES * 64 + F.tid, NGT = F.G * NWAVES * 64;
    for (int i = gt; i < NB * 4064; i += NGT) { const int b = i / 4064, r = i % 4064;
        ((f32x4*)(F.out + O_KS + (size_t)b * 16384))[r] = ((const f32x4*)(F.in[2] + (size_t)b * 16384 + 128))[r];
        ((f32x4*)(F.out + O_VS + (size_t)b * 16384))[r] = ((const f32x4*)(F.in[3] + (size_t)b * 16384 + 128))[r]; }
    for (int i = gt; i < NB * 512; i += NGT) { const int b = i / 512, r = i % 512;
        ((f32x4*)(F.out + O_CS + (size_t)b * 3072))[r] = ((const f32x4*)(F.in[4] + (size_t)b * 3072 + 1024))[r]; }
}

__device__ __forceinline__ void p2_conv_naive(Frame& F) {
    const bf16* PROJ = (const bf16*)(F.ws + WS_PROJ); bf16* XC = (bf16*)(F.ws + WS_XC);
    const float* sconv = F.in[4]; const float* cw = F.in[10]; const float* cb = F.in[11];
    const int gt = F.vcu * NWAVES * 64 + F.tid, NGT = F.G * NWAVES * 64;
    for (int i = gt; i < MREAL * 256; i += NGT) { const int m = i >> 8, ch = (i & 255) * 4;
        float a[4];
#pragma unroll
        for (int e = 0; e < 4; ++e) a[e] = cb[ch + e];
#pragma unroll
        for (int j = 0; j < 4; ++j) { float xv[4] = {0.f, 0.f, 0.f, 0.f};
            if (m < MPROMPT) { const int t = m & (SEQ - 1); if (t - 3 + j >= 0) { const unsigned long long q = *(const unsigned long long*)(PROJ + (size_t)(m - 3 + j) * NPROJ + C_XBC + ch);
#pragma unroll
                    for (int e = 0; e < 4; ++e) xv[e] = bf2f((unsigned short)(q >> (16 * e))); } }
            else { const int b = m - MPROMPT;
                if (j < 3) { const f32x4 q = *(const f32x4*)(sconv + (size_t)b * 3072 + j * 1024 + ch);
#pragma unroll
                    for (int e = 0; e < 4; ++e) xv[e] = q[e]; }
                else { const unsigned long long q = *(const unsigned long long*)(PROJ + (size_t)m * NPROJ + C_XBC + ch);
#pragma unroll
                    for (int e = 0; e < 4; ++e) xv[e] = bf2f((unsigned short)(q >> (16 * e))); } }
#pragma unroll
            for (int e = 0; e < 4; ++e) a[e] += cw[j * 1024 + ch + e] * xv[e]; }
        *(unsigned long long*)(XC + (size_t)m * 1024 + ch) = (unsigned long long)pk2(silu_f(a[0]), silu_f(a[1])) | ((unsigned long long)pk2(silu_f(a[2]), silu_f(a[3])) << 32);
    }
    for (int i = gt; i < BATCH * 128 * 128; i += NGT) { const int c = i & 127, j = (i >> 7) & 127, b = i >> 14; const size_t row = (size_t)b * SEQ + (SEQ - 128) + j;
        F.out[O_KP + i] = bf2f(PROJ[row * NPROJ + C_K + c]); F.out[O_VP + i] = bf2f(PROJ[row * NPROJ + C_V + c]); }
    for (int i = gt; i < BATCH * 3 * 1024; i += NGT) { const int c = i & 1023, j = (i >> 10) % 3, b = i / 3072; F.out[O_CP + i] = bf2f(PROJ[((size_t)b * SEQ + SEQ - 3 + j) * NPROJ + C_XBC + c]); }
    for (int i = gt; i < NB * 128; i += NGT) { const int c = i & 127, b = i >> 7; const size_t row = MPROMPT + b;
        F.out[O_KS + (size_t)b * 16384 + 127 * 128 + c] = bf2f(PROJ[row * NPROJ + C_K + c]); F.out[O_VS + (size_t)b * 16384 + 127 * 128 + c] = bf2f(PROJ[row * NPROJ + C_V + c]); }
    for (int i = gt; i < NB * 1024; i += NGT) { const int c = i & 1023, b = i >> 10; F.out[O_CS + (size_t)b * 3072 + 2048 + c] = bf2f(PROJ[(size_t)(MPROMPT + b) * NPROJ + C_XBC + c]); }
}
__device__ __forceinline__ void p3_attn_naive(Frame& F) {
    const bf16* PROJ = (const bf16*)(F.ws + WS_PROJ); bf16* MIX = (bf16*)(F.ws + WS_MIX);
    const float* ck = F.in[2]; const float* cv = F.in[3]; const float* relb = F.in[6]; const float* sinks = F.in[9];
    const int gw = F.vcu * NWAVES + F.wave, NGW = F.G * NWAVES, lane = F.lane;
    for (int task = gw; task < MREAL * 8; task += NGW) { const int m = task >> 3, hh = task & 7, kvh = hh >> 2;
        const bool prompt = m < MPROMPT; const int t = m & (SEQ - 1), b = prompt ? (m >> 12) : (m - MPROMPT);
        float q[64];
        { const bf16* qp = PROJ + (size_t)m * NPROJ + C_Q + hh * 64;
#pragma unroll
          for (int d8 = 0; d8 < 8; ++d8) { const v4u w = *(const v4u*)(qp + d8 * 8);
#pragma unroll
              for (int e = 0; e < 4; ++e) { q[d8 * 8 + 2 * e] = __uint_as_float(w[e] << 16); q[d8 * 8 + 2 * e + 1] = __uint_as_float(w[e] & 0xffff0000u); } } }
        float s[2];
#pragma unroll
        for (int half = 0; half < 2; ++half) { const int i = lane + 64 * half; float acc = 0.f; bool valid = true;
            if (prompt) { const int kt = t - 127 + i; valid = kt >= 0;
                if (valid) { const bf16* kp = PROJ + (size_t)(m - 127 + i) * NPROJ + C_K + kvh * 64;
#pragma unroll
                    for (int d8 = 0; d8 < 8; ++d8) { const v4u w = *(const v4u*)(kp + d8 * 8);
#pragma unroll
                        for (int e = 0; e < 4; ++e) acc += q[d8 * 8 + 2 * e] * __uint_as_float(w[e] << 16) + q[d8 * 8 + 2 * e + 1] * __uint_as_float(w[e] & 0xffff0000u); } } }
            else if (i < 127) { const float* kp = ck + ((size_t)b * 128 + i + 1) * 128 + kvh * 64;
#pragma unroll
                for (int d4 = 0; d4 < 16; ++d4) { const f32x4 w = *(const f32x4*)(kp + d4 * 4); acc += (q[d4 * 4] * w[0] + q[d4 * 4 + 1] * w[1]) + (q[d4 * 4 + 2] * w[2] + q[d4 * 4 + 3] * w[3]); } }
            else { const bf16* kp = PROJ + (size_t)m * NPROJ + C_K + kvh * 64;
#pragma unroll
                for (int d8 = 0; d8 < 8; ++d8) { const v4u w = *(const v4u*)(kp + d8 * 8);
#pragma unroll
                    for (int e = 0; e < 4; ++e) acc += q[d8 * 8 + 2 * e] * __uint_as_float(w[e] << 16) + q[d8 * 8 + 2 * e + 1] * __uint_as_float(w[e] & 0xffff0000u); } }
            s[half] = valid ? acc * 0.125f + relb[BUCKET[127 - i] * 8 + hh] : -INFINITY; }
        const float sk = sinks[hh];
        const float mx = fmaxf(wave_max(fmaxf(s[0], s[1])), sk);
        float p0 = __expf(s[0] - mx), p1 = __expf(s[1] - mx);
        const float den = wave_sum(p0 + p1) + __expf(sk - mx), inv = 1.0f / den;
        p0 *= inv; p1 *= inv;
        float o = 0.f;
        for (int i = 0; i < 128; ++i) { const float p = __shfl(i < 64 ? p0 : p1, i & 63);
            float v = 0.f;
            if (prompt) { if (t - 127 + i >= 0) v = bf2f(PROJ[(size_t)(m - 127 + i) * NPROJ + C_V + kvh * 64 + lane]); }
            else if (i < 127) v = cv[((size_t)b * 128 + i + 1) * 128 + kvh * 64 + lane];
            else v = bf2f(PROJ[(size_t)m * NPROJ + C_V + kvh * 64 + lane]);
            o += p * v; }
        MIX[(size_t)m * 1024 + hh * 64 + lane] = (bf16)f2bf(o);
    }
}
__device__ __forceinline__ void p3_ssm_naive(Frame& F) {
    const bf16* XC = (const bf16*)(F.ws + WS_XC); const float* DT = (const float*)(F.ws + WS_DT); float* YS = (float*)(F.ws + WS_YS);
    const float* A_log = F.in[13]; const float* Dsk = F.in[14]; const float* st0 = F.in[5];
    const int gw = F.vcu * NWAVES + F.wave, NGW = F.G * NWAVES, lane = F.lane;
    for (int task = gw; task < BATCH * 8 * 64; task += NGW) { const int p = task & 63, hd = (task >> 6) & 7, b = task >> 9, g = hd >> 2;
        const float A = -expf(A_log[hd]), Dv = Dsk[hd]; float h0 = 0.f, h1 = 0.f;
        for (int t = 0; t < SEQ; ++t) { const size_t m = (size_t)b * SEQ + t;
            const float dt = DT[m * 8 + hd], x = bf2f(XC[m * 1024 + hd * 64 + p]);
            const unsigned bw = *(const unsigned*)(XC + m * 1024 + 512 + g * 128 + 2 * lane), cw = *(const unsigned*)(XC + m * 1024 + 768 + g * 128 + 2 * lane);
            const float dA = expf(dt * A), dx = dt * x;
            h0 = h0 * dA + dx * __uint_as_float(bw << 16); h1 = h1 * dA + dx * __uint_as_float(bw & 0xffff0000u);
            const float y = wave_sum(__uint_as_float(cw << 16) * h0 + __uint_as_float(cw & 0xffff0000u) * h1);
            if (lane == 0) YS[m * 512 + hd * 64 + p] = y + Dv * x; }
        F.out[O_SP + ((size_t)((b * 8 + hd) * 64 + p)) * 128 + 2 * lane] = h0; F.out[O_SP + ((size_t)((b * 8 + hd) * 64 + p)) * 128 + 2 * lane + 1] = h1;
    }
    for (int task = gw; task < NB * 8 * 64; task += NGW) { const int p = task & 63, hd = (task >> 6) & 7, b = task >> 9, g = hd >> 2; const size_t m = MPROMPT + b;
        const float A = -expf(A_log[hd]), Dv = Dsk[hd]; const size_t so = ((size_t)((b * 8 + hd) * 64 + p)) * 128 + 2 * lane;
        float h0 = st0[so], h1 = st0[so + 1];
        const float dt = DT[m * 8 + hd], x = bf2f(XC[m * 1024 + hd * 64 + p]);
        const unsigned bw = *(const unsigned*)(XC + m * 1024 + 512 + g * 128 + 2 * lane), cw = *(const unsigned*)(XC + m * 1024 + 768 + g * 128 + 2 * lane);
        const float dA = expf(dt * A), dx = dt * x;
        h0 = h0 * dA + dx * __uint_as_float(bw << 16); h1 = h1 * dA + dx * __uint_as_float(bw & 0xffff0000u);
        const float y = wave_sum(__uint_as_float(cw << 16) * h0 + __uint_as_float(cw & 0xffff0000u) * h1);
        if (lane == 0) YS[m * 512 + hd * 64 + p] = y + Dv * x;
        F.out[O_SS + so] = h0; F.out[O_SS + so + 1] = h1;
    }
}
__device__ __forceinline__ void p4_gate_naive(Frame& F) {
    const bf16* PROJ = (const bf16*)(F.ws + WS_PROJ); bf16* MIX = (bf16*)(F.ws + WS_MIX); const float* YS = (const float*)(F.ws + WS_YS); const float* nw = F.in[15];
    const int gw = F.vcu * NWAVES + F.wave, NGW = F.G * NWAVES, lane = F.lane;
    for (int task = gw; task < MREAL * 2; task += NGW) { const int m = task >> 1, ch = (task & 1) * 256 + 4 * lane;
        const f32x4 y = *(const f32x4*)(YS + (size_t)m * 512 + ch); const unsigned long long zq = *(const unsigned long long*)(PROJ + (size_t)m * NPROJ + C_Z + ch);
        float v[4]; float s = 0.f;
#pragma unroll
        for (int e = 0; e < 4; ++e) { v[e] = y[e] * silu_f(bf2f((unsigned short)(zq >> (16 * e)))); s += v[e] * v[e]; }
        const float rstd = 1.0f / sqrtf(wave_sum(s) * (1.0f / 256.0f) + EPS); const f32x4 w = *(const f32x4*)(nw + ch);
        *(unsigned long long*)(MIX + (size_t)m * 1024 + 512 + ch) = (unsigned long long)pk2(v[0] * rstd * w[0], v[1] * rstd * w[1]) | ((unsigned long long)pk2(v[2] * rstd * w[2], v[3] * rstd * w[3]) << 32);
    }
}
__device__ __forceinline__ void p8_final_norm(Frame& F) {
    const float* wf = F.in[21];
    const int gw = F.vcu * NWAVES + F.wave, NGW = F.G * NWAVES;
    f32x4 w[4];
#pragma unroll
    for (int j = 0; j < 4; ++j) w[j] = ((const f32x4*)wf)[64 * j + F.lane];
    for (int m = gw; m < MREAL; m += NGW) { f32x4* xr = (f32x4*)(F.out + (size_t)m * DM) + F.lane; f32x4 v[4]; float s = 0.f;
#pragma unroll
        for (int j = 0; j < 4; ++j) { v[j] = xr[64 * j]; s += (v[j][0] * v[j][0] + v[j][1] * v[j][1]) + (v[j][2] * v[j][2] + v[j][3] * v[j][3]); }
        const float rstd = 1.0f / sqrtf(wave_sum(s) * (1.0f / DM) + EPS);
#pragma unroll
        for (int j = 0; j < 4; ++j) xr[64 * j] = v[j] * rstd * w[j]; }
}

struct Args { const float* in[22]; float* out; unsigned char* ws; int ph_lo, ph_hi; };
constexpr int N_PHASES = 9;
#ifndef MK_ONE_LAUNCH
#define MK_ONE_LAUNCH 1
#endif
__global__ void __launch_bounds__(NWAVES * 64, 2) hymba_fwd(Args args) {
    extern __shared__ __attribute__((aligned(16))) unsigned char lds[];
    Frame F;
    F.lds = (LAS unsigned char*)lds;
    F.tid = threadIdx.x; F.lane = F.tid & 63; F.wave = __builtin_amdgcn_readfirstlane(F.tid >> 6);
    F.G = gridDim.x; { const int bx = blockIdx.x; F.vcu = (F.G % 8 == 0) ? (bx % 8) * (F.G / 8) + bx / 8 : bx; }
#pragma unroll
    for (int i = 0; i < 22; ++i) F.in[i] = args.in[i];
    F.out = args.out; F.ws = args.ws;
    volatile LAS unsigned* MISC = (volatile LAS unsigned*)(F.lds + MISC_OFF);
    if (F.tid < 64) MISC[F.tid] = 0u;
    __syncthreads();
    gu32* ctl = (gu32*)(F.ws + WS_CTL);
    XcdBarrier bar; bar.bar = (unsigned*)(ctl + CW_BAR); bar.x = 0; bar.st = nullptr;
    const int lo = args.ph_lo, hi = args.ph_hi;
    if (hi - lo > 1) bar = xcd_barrier_post((unsigned*)(ctl + CW_BAR), MISC + 8);
#define IN(k) (lo <= (k) && (k) < hi)
#define SEAM(k) do { if (IN(k) && IN((k) + 1)) xcd_barrier(bar); } while (0)
    bf16* XN = (bf16*)(F.ws + WS_XN); bf16* PROJ = (bf16*)(F.ws + WS_PROJ); bf16* MIX = (bf16*)(F.ws + WS_MIX); bf16* HB = (bf16*)(F.ws + WS_PROJ);
    float* SSQ1 = (float*)(F.ws + WS_SSQ1);
    if (IN(0)) { p0_prologue(F); SEAM(0); }
    if (IN(1)) {
        pg8::Gemm g{XN, (const bf16*)(F.ws + WS_WIN), MP, NPROJ, DM}; pg8::StaticOrder S; S.init(MP, NPROJ, F.G, (int)blockIdx.x);
        pg8::EpiStoreBf16 E{PROJ, NPROJ};
        pg8::gemm_phase<pg8::EpiStoreBf16, pg8::StaticOrder, true, true>(F.lds + RING_OFF, g, S, E);
        SEAM(1);
    }
    if (IN(2)) { p2_conv_naive(F); SEAM(2); }
    if (IN(3)) { p3_ssm_naive(F); p3_attn_naive(F); SEAM(3); }
    if (IN(4)) { p4_gate_naive(F); SEAM(4); }
    if (IN(5)) {
        pg8::Gemm g{MIX, (const bf16*)(F.ws + WS_WOUT), MP, DM, DM}; pg8::StaticOrder S; S.init(MP, DM, F.G, (int)blockIdx.x);
        pg8::EpiResid E{F.in[0], F.in[1], MPROMPT, F.out, XN, SSQ1, MREAL};
        pg8::gemm_phase<pg8::EpiResid, pg8::StaticOrder, true, true>(F.lds + RING_OFF, g, S, E);
        SEAM(5);
    }
    if (IN(6)) {
        pg8::Gemm g{XN, (const bf16*)(F.ws + WS_WGU), MP, NGU, DM}; pg8::StaticOrder S; S.init(MP, NGU, F.G, (int)blockIdx.x);
        pg8::EpiSwiglu E{HB, DFF, SSQ1, EPS};
        pg8::gemm_phase<pg8::EpiSwiglu, pg8::StaticOrder, true, true>(F.lds + RING_OFF, g, S, E);
        SEAM(6);
    }
    if (IN(7)) {
        pg8::Gemm g{HB, (const bf16*)(F.ws + WS_WD), MP, DM, DFF}; pg8::StaticOrder S; S.init(MP, DM, F.G, (int)blockIdx.x);
        pg8::EpiResid E{F.out, F.out, MP, F.out, nullptr, nullptr, MREAL};
        pg8::gemm_phase<pg8::EpiResid, pg8::StaticOrder, true, true>(F.lds + RING_OFF, g, S, E);
        SEAM(7);
    }
    if (IN(8)) { p8_final_norm(F); }
#undef IN
#undef SEAM
}

extern "C" void kernel_launch(void* const* d_in, const int* in_sizes, int n_in, void* d_out, int out_size, void* d_ws, size_t ws_size, hipStream_t stream) {
    static int grid = 0;
    if (grid == 0) {
        if (n_in != 22 || (size_t)out_size != O_END || ws_size < WS_END) { fprintf(stderr, "kernel_launch: unexpected shapes (n_in %d out %d ws %zu)\n", n_in, out_size, ws_size); grid = -1; return; }
        int dev = 0, cus = 0;
        if (hipGetDevice(&dev) != hipSuccess || hipDeviceGetAttribute(&cus, hipDeviceAttributeMultiprocessorCount, dev) != hipSuccess) { grid = -1; return; }
        if (hipFuncSetAttribute((const void*)hymba_fwd, hipFuncAttributeMaxDynamicSharedMemorySize, LDS_BYTES) != hipSuccess) { fprintf(stderr, "kernel_launch: hipFuncSetAttribute failed\n"); grid = -1; return; }
        int per_cu = 0;
        if (hipOccupancyMaxActiveBlocksPerMultiprocessor(&per_cu, (const void*)hymba_fwd, NWAVES * 64, LDS_BYTES) != hipSuccess || per_cu < 1) fprintf(stderr, "kernel_launch: occupancy query reports %d\n", per_cu);
        (void)hipGetLastError();
        grid = cus;
    }
    if (grid < 0) return;
    if (hipMemsetAsync((char*)d_ws + WS_CTL, 0, CTL_ZERO_BYTES, stream) != hipSuccess) return;
    Args a{};
    for (int i = 0; i < 22; ++i) a.in[i] = (const float*)d_in[i];
    a.out = (float*)d_out; a.ws = (unsigned char*)d_ws;
#if MK_ONE_LAUNCH
    a.ph_lo = 0; a.ph_hi = N_PHASES;
    hipLaunchKernelGGL(hymba_fwd, dim3(grid), dim3(NWAVES * 64), LDS_BYTES, stream, a);
#else
    for (int p = 0; p < N_PHASES; ++p) { a.ph_lo = p; a.ph_hi = p + 1; hipLaunchKernelGGL(hymba_fwd, dim3(grid), dim3(NWAVES * 64), LDS_BYTES, stream, a); }
#endif
}
```

```cpp
#include <hip/hip_runtime.h>
#include <cstdio>
#include <cstdint>
namespace pg8 {
#define PG8_LAS __attribute__((address_space(3)))
typedef unsigned short bf16_t;
typedef short bf16x8 __attribute__((ext_vector_type(8)));
typedef float f32x4 __attribute__((ext_vector_type(4)));
typedef unsigned u32x4 __attribute__((ext_vector_type(4)));
constexpr int BM = 256, BK = 64, HALF = 128, HTB = HALF * BK * 2  , STAGE_BYTES = 8 * HTB, NXCD = 8, WGM = 8;

__host__ __device__ __forceinline__ int lds_byte(int r, int c) { const int st = (r >> 4) * 2 + (c >> 5), rr = r & 15, cc = c & 31, ob = rr * 64 + cc * 2; return st * 1024 + (ob ^ (((ob >> 9) & 1) << 5)); }
__host__ __device__ __forceinline__ void stage_rc(int b, int& R, int& C) { const int st = b / 1024, sb = b % 1024, swz = sb ^ (((sb >> 9) & 1) << 5); R = (st >> 1) * 16 + swz / 64; C = (st & 1) * 32 + (swz % 64) / 2; }
__host__ __device__ __forceinline__ int perm32(int rho) { const int n = rho >> 4, i = rho & 15; return 8 * (i >> 2) + 4 * n + (i & 3); }

struct Unit { int pm, pn; };
struct Gemm { const bf16_t* A; const bf16_t* Bt; int M, N, K; };

struct StaticOrder {
    int nM, nN, nwg, G, c;
    __host__ __device__ void init(int M, int N, int G_, int c_) { nM = M / BM; nN = N / BM; nwg = nM * nN; G = G_; c = c_; }
    __host__ __device__ bool next(int i, Unit& u) const {
        const long L = (long)i * G + c; if (L >= nwg) return false;
        int wgid = (int)L; { const int q = nwg / NXCD, r = nwg % NXCD, xcd = wgid % NXCD, off = wgid / NXCD; wgid = (xcd < r ? xcd * (q + 1) : r * (q + 1) + (xcd - r) * q) + off; }
        const int nig = WGM * nN, gid = wgid / nig, fm = gid * WGM, gsz = (nM - fm) < WGM ? (nM - fm) : WGM;
        u.pm = fm + ((wgid % nig) % gsz); u.pn = (wgid % nig) / gsz; return true;
    }
    __device__ __forceinline__ void a_ready(const Unit&) const {}
    __device__ __forceinline__ void done(const Unit&) const {}
};

__device__ __forceinline__ unsigned cvt_pk_bf16(float lo, float hi) { unsigned r; asm volatile("v_cvt_pk_bf16_f32 %0, %1, %2" : "=v"(r) : "v"(lo), "v"(hi)); return r; }
typedef unsigned u32x2 __attribute__((ext_vector_type(2)));
struct EpiStoreBf16 {
    static constexpr bool PERM = true, AFTER_DRAIN = false;
    bf16_t* O; int ldc;
    __device__ __forceinline__ void operator()(const f32x4 (&acc)[2][2][4][2], const Unit& u, int wr, int wc, int fr, int fq) const {
        const int row0 = u.pm * BM + wr * 64 + fr, col0 = u.pn * BM + wc * 32 + 8 * fq;
#pragma unroll
        for (int ai = 0; ai < 2; ++ai)
#pragma unroll
            for (int m = 0; m < 4; ++m) { bf16_t* rowp = O + (size_t)(row0 + ai * HALF + m * 16) * ldc + col0;
#pragma unroll
                for (int bj = 0; bj < 2; ++bj) { const f32x4 v0 = acc[ai][bj][m][0], v1 = acc[ai][bj][m][1];
                    u32x4 w; w.x = cvt_pk_bf16(v0[0], v0[1]); w.y = cvt_pk_bf16(v0[2], v0[3]); w.z = cvt_pk_bf16(v1[0], v1[1]); w.w = cvt_pk_bf16(v1[2], v1[3]);
                    *(u32x4*)(rowp + bj * HALF) = w; } }
    }
};
struct EpiResid {
    static constexpr bool PERM = false, AFTER_DRAIN = false;
    const float* base0; const float* base1; int split; float* out; bf16_t* xb; float* ssq; int mreal;
    __device__ __forceinline__ void operator()(const f32x4 (&acc)[2][2][4][2], const Unit& u, int wr, int wc, int fr, int fq) const {
        const int col0 = u.pn * BM + wc * 32 + 4 * fq;
#pragma unroll
        for (int ai = 0; ai < 2; ++ai)
#pragma unroll
            for (int m = 0; m < 4; ++m) { const int row = u.pm * BM + ai * HALF + wr * 64 + m * 16 + fr;
                float s = 0.f;
                if (row < mreal) {
                    const float* bp = (row < split ? base0 + (size_t)row * 1024 : base1 + (size_t)(row - split) * 1024) + col0;
                    float* op = out + (size_t)row * 1024 + col0;
#pragma unroll
                    for (int bj = 0; bj < 2; ++bj)
#pragma unroll
                        for (int n = 0; n < 2; ++n) { const f32x4 v = *(const f32x4*)(bp + bj * HALF + n * 16) + acc[ai][bj][m][n];
                            *(f32x4*)(op + bj * HALF + n * 16) = v; s += (v[0] * v[0] + v[1] * v[1]) + (v[2] * v[2] + v[3] * v[3]);
                            if (xb) { u32x2 w; w.x = cvt_pk_bf16(v[0], v[1]); w.y = cvt_pk_bf16(v[2], v[3]); *(u32x2*)(xb + (size_t)row * 1024 + col0 + bj * HALF + n * 16) = w; } }
                }
                if (ssq) { s += __shfl_xor(s, 16); s += __shfl_xor(s, 32); if (fq == 0 && row < mreal) ssq[(size_t)row * 16 + u.pn * 4 + wc] = s; }
            }
    }
};
struct EpiSwiglu {
    static constexpr bool PERM = true, AFTER_DRAIN = false;
    bf16_t* H; int ldh; const float* ssq; float eps;
    __device__ __forceinline__ void operator()(const f32x4 (&acc)[2][2][4][2], const Unit& u, int wr, int wc, int fr, int fq) const {
        const int row0 = u.pm * BM + wr * 64 + fr, hcol0 = (u.pn * BM + wc * 32 + 8 * fq) >> 1;
#pragma unroll
        for (int ai = 0; ai < 2; ++ai)
#pragma unroll
            for (int m = 0; m < 4; ++m) { const int row = row0 + ai * HALF + m * 16;
                const f32x4* sp = (const f32x4*)(ssq + (size_t)row * 16); const f32x4 s0 = sp[0], s1 = sp[1], s2 = sp[2], s3 = sp[3];
                const float sum = ((s0[0] + s0[1]) + (s0[2] + s0[3])) + ((s1[0] + s1[1]) + (s1[2] + s1[3])) + ((s2[0] + s2[1]) + (s2[2] + s2[3])) + ((s3[0] + s3[1]) + (s3[2] + s3[3]));
                const float rstd = 1.0f / sqrtf(sum * (1.0f / 1024.0f) + eps);
#pragma unroll
                for (int bj = 0; bj < 2; ++bj) { const f32x4 g = acc[ai][bj][m][0] * rstd, up = acc[ai][bj][m][1] * rstd; float hv[4];
#pragma unroll
                    for (int e = 0; e < 4; ++e) hv[e] = g[e] * __builtin_amdgcn_rcpf(1.0f + __expf(-g[e])) * up[e];
                    u32x2 w; w.x = cvt_pk_bf16(hv[0], hv[1]); w.y = cvt_pk_bf16(hv[2], hv[3]);
                    *(u32x2*)(H + (size_t)row * ldh + hcol0 + bj * (HALF / 2)) = w; } }
    }
};
template <class Epi, class Sched, bool ALIGN_EPI = false, bool SP2 = false>
__device__ __forceinline__ void gemm_phase(PG8_LAS unsigned char* lds, const Gemm g, const Sched& S, const Epi& E) {
    const int tid = threadIdx.x, wid = __builtin_amdgcn_readfirstlane(tid >> 6), lane = tid & 63, wr = wid >> 2, wc = wid & 3, fr = lane & 15, fq = lane >> 4;
    const int K = g.K, nt = K / BK;
    unsigned voffA[2], voffB[2];
#pragma unroll
    for (int i = 0; i < 2; ++i) { int R, C; stage_rc(tid * 16 + i * 8192, R, C); const int Rb = Epi::PERM ? ((R & ~31) + perm32(R & 31)) : R;
        voffA[i] = (unsigned)(R * K + C) * 2u; voffB[i] = (unsigned)(Rb * K + C) * 2u; }
    const size_t kstep = (size_t)(BK * 2);
    const size_t hstep = (size_t)HALF * K * 2;
    const size_t tstep = 2 * hstep;
    const unsigned ldsw = (unsigned)wid * 1024u;
    const int aoff = lds_byte(wr * 64 + fr, fq * 8), boff = lds_byte(wc * 32 + fr, fq * 8);
#define PG8_SA(b, h) (((b) * 2 + (h)) * HTB)
#define PG8_SB(b, h) ((4 + (b) * 2 + (h)) * HTB)
#define PG8_STAGE(bufoff, gbase, voff) do { _Pragma("unroll") for (int _i = 0; _i < 2; ++_i) \
        __builtin_amdgcn_global_load_lds((const unsigned*)((const char*)(gbase) + (voff)[_i]), (PG8_LAS unsigned*)(lds + (bufoff) + ldsw + _i * 8192), 16, 0, 0); } while (0)
#define PG8_LDA(dst, b, h) do { _Pragma("unroll") for (int m = 0; m < 4; ++m) _Pragma("unroll") for (int k = 0; k < 2; ++k) dst[m][k] = *(const PG8_LAS bf16x8*)(lds + PG8_SA(b, h) + aoff + m * 2048 + k * 1024); } while (0)
#define PG8_LDB(dst, b, h) do { _Pragma("unroll") for (int n = 0; n < 2; ++n) _Pragma("unroll") for (int k = 0; k < 2; ++k) dst[n][k] = *(const PG8_LAS bf16x8*)(lds + PG8_SB(b, h) + boff + n * 2048 + k * 1024); } while (0)
#define PG8_MMA(ai, bj, At, Bt) do { __builtin_amdgcn_s_setprio(1); _Pragma("unroll") for (int m = 0; m < 4; ++m) _Pragma("unroll") for (int n = 0; n < 2; ++n) _Pragma("unroll") for (int k = 0; k < 2; ++k) \
        acc[ai][bj][m][n] = __builtin_amdgcn_mfma_f32_16x16x32_bf16(Bt[n][k], At[m][k], acc[ai][bj][m][n], 0, 0, 0); __builtin_amdgcn_s_setprio(0); } while (0)
#define PG8_WAIT_V(n) asm volatile("s_waitcnt vmcnt(" #n ")" ::: "memory")
#define PG8_WAIT_L(n) asm volatile("s_waitcnt lgkmcnt(" #n ")" ::: "memory")
#define PG8_BAR __builtin_amdgcn_s_barrier()
#define PG8_SCHED __builtin_amdgcn_sched_barrier(0)
    Unit cur, nxt; int ui = 0;
    if (!S.next(0, cur)) return;
    f32x4 acc[2][2][4][2];
#pragma unroll
    for (int a = 0; a < 2; ++a)
#pragma unroll
        for (int b = 0; b < 2; ++b)
#pragma unroll
            for (int m = 0; m < 4; ++m)
#pragma unroll
                for (int n = 0; n < 2; ++n) acc[a][b][m][n] = (f32x4){0.f, 0.f, 0.f, 0.f};
    bf16x8 At[4][2], B0[2][2], B1[2][2];
    const char* cA = (const char*)g.A + (size_t)cur.pm * tstep; const char* cB = (const char*)g.Bt + (size_t)cur.pn * tstep;
    S.a_ready(cur);
    if constexpr (SP2) {
        PG8_STAGE(PG8_SB(0, 0), cB, voffB); PG8_STAGE(PG8_SB(0, 1), cB + hstep, voffB); PG8_STAGE(PG8_SA(0, 0), cA, voffA); PG8_STAGE(PG8_SA(0, 1), cA + hstep, voffA);
        if (wr == 1) PG8_BAR;
        PG8_WAIT_V(2); PG8_BAR;
        PG8_STAGE(PG8_SB(1, 0), cB + kstep, voffB); PG8_STAGE(PG8_SA(1, 0), cA + kstep, voffA); PG8_STAGE(PG8_SB(1, 1), cB + hstep + kstep, voffB);
        PG8_WAIT_V(6); PG8_BAR;
    } else {
        PG8_STAGE(PG8_SB(0, 0), cB, voffB); PG8_STAGE(PG8_SA(0, 0), cA, voffA); PG8_STAGE(PG8_SB(0, 1), cB + hstep, voffB); PG8_STAGE(PG8_SA(0, 1), cA + hstep, voffA);
        if (wr == 1) PG8_BAR;
        PG8_WAIT_V(4); PG8_BAR;
        PG8_STAGE(PG8_SB(1, 0), cB + kstep, voffB); PG8_STAGE(PG8_SA(1, 0), cA + kstep, voffA); PG8_STAGE(PG8_SB(1, 1), cB + hstep + kstep, voffB);
        PG8_WAIT_V(6); PG8_BAR;
    }
    for (;;) {
        const bool has_next = S.next(ui + 1, nxt);
        const char* nA = has_next ? (const char*)g.A + (size_t)nxt.pm * tstep : cA; const char* nB = has_next ? (const char*)g.Bt + (size_t)nxt.pn * tstep : cB;
        for (int t = 0; t < nt; t += 2) {
            const bool last = (t == nt - 2);
            const char* a1 = cA + (size_t)(t + 1) * kstep;
            const char* a2 = last ? nA : cA + (size_t)(t + 2) * kstep; const char* b2 = last ? nB : cB + (size_t)(t + 2) * kstep;
            const char* a3 = a2 + kstep; const char* b3 = b2 + kstep;
            if (last && has_next) S.a_ready(nxt);
            if constexpr (SP2) {
            PG8_LDB(B0, 0, 0); PG8_LDB(B1, 0, 1); PG8_SCHED; PG8_LDA(At, 0, 0); PG8_STAGE(PG8_SA(1, 1), a1 + hstep, voffA);
            PG8_WAIT_V(8); PG8_WAIT_L(0); PG8_BAR; PG8_MMA(0, 0, At, B0); PG8_MMA(0, 1, At, B1); PG8_BAR; PG8_SCHED;
            PG8_LDA(At, 0, 1); PG8_STAGE(PG8_SB(0, 0), b2, voffB); PG8_STAGE(PG8_SB(0, 1), b2 + hstep, voffB); PG8_STAGE(PG8_SA(0, 0), a2, voffA);
            PG8_WAIT_V(8); PG8_WAIT_L(0); PG8_BAR; PG8_MMA(1, 0, At, B0); PG8_MMA(1, 1, At, B1); PG8_BAR; PG8_SCHED;
            PG8_LDB(B0, 1, 0); PG8_LDB(B1, 1, 1); PG8_SCHED; PG8_LDA(At, 1, 0); PG8_STAGE(PG8_SA(0, 1), a2 + hstep, voffA);
            PG8_WAIT_V(8); PG8_WAIT_L(0); PG8_BAR; PG8_MMA(0, 0, At, B0); PG8_MMA(0, 1, At, B1); PG8_BAR; PG8_SCHED;
            PG8_LDA(At, 1, 1); PG8_STAGE(PG8_SB(1, 0), b3, voffB); PG8_STAGE(PG8_SB(1, 1), b3 + hstep, voffB); PG8_STAGE(PG8_SA(1, 0), a3, voffA);
            PG8_WAIT_V(8); PG8_WAIT_L(0); PG8_BAR; PG8_MMA(1, 0, At, B0); PG8_MMA(1, 1, At, B1); PG8_BAR; PG8_SCHED;
            } else {
            PG8_LDB(B0, 0, 0); PG8_SCHED; PG8_LDA(At, 0, 0); PG8_STAGE(PG8_SA(1, 1), a1 + hstep, voffA);
            PG8_WAIT_L(8); PG8_BAR; PG8_WAIT_L(0); PG8_MMA(0, 0, At, B0); PG8_BAR; PG8_SCHED;
            PG8_LDB(B1, 0, 1); PG8_STAGE(PG8_SB(0, 0), b2, voffB);
            PG8_BAR; PG8_WAIT_L(0); PG8_MMA(0, 1, At, B1); PG8_BAR;
            PG8_LDA(At, 0, 1); PG8_STAGE(PG8_SA(0, 0), a2, voffA);
            PG8_BAR; PG8_WAIT_L(0); PG8_MMA(1, 0, At, B0); PG8_BAR; PG8_SCHED;
            PG8_STAGE(PG8_SB(0, 1), b2 + hstep, voffB);
            PG8_WAIT_V(6); PG8_BAR; PG8_MMA(1, 1, At, B1); PG8_BAR;
            PG8_LDB(B0, 1, 0); PG8_SCHED; PG8_LDA(At, 1, 0); PG8_STAGE(PG8_SA(0, 1), a2 + hstep, voffA);
            PG8_WAIT_L(8); PG8_BAR; PG8_WAIT_L(0); PG8_MMA(0, 0, At, B0); PG8_BAR; PG8_SCHED;
            PG8_LDB(B1, 1, 1); PG8_STAGE(PG8_SB(1, 0), b3, voffB);
            PG8_BAR; PG8_WAIT_L(0); PG8_MMA(0, 1, At, B1); PG8_BAR;
            PG8_LDA(At, 1, 1); PG8_STAGE(PG8_SA(1, 0), a3, voffA);
            PG8_BAR; PG8_WAIT_L(0); PG8_MMA(1, 0, At, B0); PG8_BAR; PG8_SCHED;
            PG8_STAGE(PG8_SB(1, 1), b3 + hstep, voffB);
            PG8_WAIT_V(6); PG8_BAR; PG8_MMA(1, 1, At, B1); PG8_BAR;
            }
        }
        if constexpr (ALIGN_EPI) { if (wr == 0) PG8_BAR; }
        if constexpr (!Epi::AFTER_DRAIN) { E(acc, cur, wr, wc, fr, fq); S.done(cur); }
        if (!has_next) break;
#pragma unroll
        for (int a = 0; a < 2; ++a)
#pragma unroll
            for (int b = 0; b < 2; ++b)
#pragma unroll
                for (int m = 0; m < 4; ++m)
#pragma unroll
                    for (int n = 0; n < 2; ++n) acc[a][b][m][n] = (f32x4){0.f, 0.f, 0.f, 0.f};
        cur = nxt; cA = nA; cB = nB; ++ui;
        if constexpr (ALIGN_EPI) { if (wr == 1) PG8_BAR; }
    }
    PG8_WAIT_V(0);
    if constexpr (!ALIGN_EPI) { if (wr == 0) PG8_BAR; }
    PG8_BAR;
    if constexpr (Epi::AFTER_DRAIN) { E.fused(acc, cur, wr, wc, fr, fq, lds, wid, lane); S.done(cur); }
#undef PG8_SA
#undef PG8_SB
#undef PG8_STAGE
#undef PG8_LDA
#undef PG8_LDB
#undef PG8_MMA
#undef PG8_WAIT_V
#undef PG8_WAIT_L
#undef PG8_BAR
#undef PG8_SCHED
}
}
#define GAS __attribute__((address_space(1)))
#define LAS __attribute__((address_space(3)))
typedef unsigned short bf16;
typedef unsigned v4u __attribute__((ext_vector_type(4)));
typedef float f32x4 __attribute__((ext_vector_type(4)));
typedef short bf16x8 __attribute__((ext_vector_type(8)));
typedef GAS unsigned gu32;
typedef GAS unsigned long long gu64;
#define RLX_AGENT __ATOMIC_RELAXED, __HIP_MEMORY_SCOPE_AGENT
#define LDS_WAIT() asm volatile("s_waitcnt lgkmcnt(0)" ::: "memory")
#define VM_WAIT() asm volatile("s_waitcnt vmcnt(0)" ::: "memory")
__device__ __forceinline__ unsigned long long rt() { return __builtin_amdgcn_s_memrealtime(); }
__device__ __forceinline__ unsigned f2bf(float f) { unsigned u = __builtin_bit_cast(unsigned, f); return (u + 0x7fffu + ((u >> 16) & 1u)) >> 16; }
__device__ __forceinline__ unsigned pk2(float lo, float hi) { return f2bf(lo) | (f2bf(hi) << 16); }

#define XB_TMO      128
#define XB_XCNT(j)  (256  + 64 * (j))
#define XB_XSUB(j)  (1280 + 64 * (j))
#define XB_XGEN(j)  (2304 + 64 * (j))
#define XB_TOP      3328
#define XB_TOPGEN   3392
#define XCD_BAR_WORDS 3456
#define XB_SPIN_CAP (1u << 18)

__device__ __forceinline__ unsigned xb_ld(unsigned* p)              { return __hip_atomic_load(p, __ATOMIC_RELAXED, __HIP_MEMORY_SCOPE_AGENT); }
__device__ __forceinline__ unsigned xb_add(unsigned* p, unsigned v) { return __hip_atomic_fetch_add(p, v, __ATOMIC_RELAXED, __HIP_MEMORY_SCOPE_AGENT); }
__device__ __forceinline__ unsigned xb_xcc_id() { return (unsigned)__builtin_amdgcn_s_getreg((3 << 11) | 20) & 0xFu; }
#define XB_SPIN(cond, bar) do { unsigned _sp = 0; while (cond) { __builtin_amdgcn_s_sleep(1); \
    if ((++_sp & 255u) == 0u) { if (xb_ld(&(bar)[XB_TMO])) break; if (_sp > XB_SPIN_CAP) { atomicAdd(&(bar)[XB_TMO], 1u); break; } } } } while (0)

struct XcdBarrier {
    unsigned* bar; unsigned x;
    volatile LAS unsigned* st;
};

__device__ __forceinline__ XcdBarrier xcd_barrier_post(unsigned* bar, volatile LAS unsigned* st) {
    XcdBarrier b; b.bar = bar; b.x = xb_xcc_id(); b.st = st;
    if (threadIdx.x == 0) (void)xb_add(&bar[XB_XCNT(b.x)], 1u);
    return b;
}
__device__ __forceinline__ void xcd_barrier_complete(unsigned* bar, unsigned x, unsigned& nloc, unsigned& nx) {
    const unsigned G = gridDim.x * gridDim.y * gridDim.z;
    unsigned sum, cnt, mine, sp = 0u;
    for (;;) {
        sum = 0u; cnt = 0u; mine = 0u;
#pragma unroll
        for (unsigned j = 0; j < 16; ++j) { const unsigned c = xb_ld(&bar[XB_XCNT(j)]); sum += c; cnt += (c > 0u) ? 1u : 0u; mine = (j == x) ? c : mine; }
        if (sum == G) break;
        __builtin_amdgcn_s_sleep(1);
        if ((++sp & 255u) == 0u) { if (xb_ld(&bar[XB_TMO])) break; if (sp > XB_SPIN_CAP) { atomicAdd(&bar[XB_TMO], 1u); break; } }
    }
    nloc = mine > 0u ? mine : 1u; nx = cnt > 0u ? cnt : 1u;
}

__device__ __forceinline__ void xcd_barrier(const XcdBarrier& b) {
    asm volatile("s_waitcnt vmcnt(0)" ::: "memory");
    __syncthreads();
    if (threadIdx.x == 0) {
        unsigned* bar = b.bar;
        __builtin_amdgcn_s_waitcnt(0);
        unsigned nloc = b.st[0], nx = b.st[1];
        if (nloc == 0u) { xcd_barrier_complete(bar, b.x, nloc, nx); b.st[0] = nloc; b.st[1] = nx; }
        const unsigned old = xb_add(&bar[XB_XSUB(b.x)], 1u);
        const unsigned gen = old / nloc;
        if (old + 1u == (gen + 1u) * nloc) {
            __builtin_amdgcn_fence(__ATOMIC_RELEASE, "agent");
            asm volatile("s_waitcnt vmcnt(0)" ::: "memory");
            const unsigned og = xb_add(&bar[XB_TOP], 1u);
            const unsigned tg = og / nx;
            if (og + 1u == (tg + 1u) * nx) xb_add(&bar[XB_TOPGEN], 1u);
            else XB_SPIN(xb_ld(&bar[XB_TOPGEN]) == tg, bar);
            __builtin_amdgcn_fence(__ATOMIC_ACQUIRE, "agent");
            xb_add(&bar[XB_XGEN(b.x)], 1u);
            asm volatile("s_waitcnt vmcnt(0)" ::: "memory");
        } else {
            XB_SPIN(xb_ld(&bar[XB_XGEN(b.x)]) == gen, bar);
            __builtin_amdgcn_fence(__ATOMIC_ACQUIRE, "agent");
            asm volatile("s_waitcnt vmcnt(0)" ::: "memory");
        }
    }
    __syncthreads();
}
constexpr int NWAVES = 8;
constexpr int DM = 1024, BATCH = 4, SEQ = 4096, NB = 128  , MPROMPT = BATCH * SEQ, MREAL = MPROMPT + NB, MP = 16640  ;
constexpr int NPROJ = 2304, LDW_IN = 2312, DFF = 2816, NGU = 2 * DFF;
constexpr int C_Q = 0, C_K = 512, C_V = 640, C_Z = 768, C_XBC = 1280, C_B = 1792, C_C = 2048;
constexpr float EPS = 1e-6f;
constexpr size_t O_YP = 0, O_YS = 16777216, O_KP = 16908288, O_VP = 16973824, O_CP = 17039360, O_SP = 17051648, O_KS = 17313792, O_VS = 19410944, O_CS = 21508096, O_SS = 21901312, O_END = 30289920;
constexpr size_t MiB = 1u << 20;
constexpr size_t WS_CTL = 0, CTL_ZERO_BYTES = 1 * MiB;
constexpr size_t WS_WIN = 2 * MiB;
constexpr size_t WS_WOUT = 7 * MiB;
constexpr size_t WS_WGU = 9 * MiB;
constexpr size_t WS_WD = 20 * MiB;
constexpr size_t WS_DT = 26 * MiB;
constexpr size_t WS_SSQ1 = 27 * MiB;
constexpr size_t WS_XN = 32 * MiB;
constexpr size_t WS_PROJ = 66 * MiB;
constexpr size_t WS_MIX = 140 * MiB;
constexpr size_t WS_YS = 174 * MiB;
constexpr size_t WS_XC = 208 * MiB;
constexpr size_t WS_END = 256 * MiB;
static_assert(WS_PROJ + (size_t)MP * DFF * 2 <= WS_YS && WS_XC + (size_t)MP * 1024 * 2 <= WS_END, "ws map");
constexpr int CW_BAR = 4096;

constexpr int RING_OFF = 0, RING_BYTES = 131072;
constexpr int LDS_BYTES = 163840;
constexpr int MISC_OFF = LDS_BYTES - 256;

__device__ const unsigned char BUCKET[128] = {0, 1, 2, 3, 4, 5, 6, 7, 8, 9, 10, 11, 12, 13, 14, 15, 16, 16, 16, 17, 17, 18, 18, 18, 19, 19, 19, 20, 20, 20, 20, 21, 21, 21, 21, 22, 22, 22, 22, 22, 23, 23, 23, 23, 23, 23, 24, 24, 24, 24, 24, 24, 25, 25, 25, 25, 25, 25, 25, 26, 26, 26, 26, 26, 26, 26, 26, 27, 27, 27, 27, 27, 27, 27, 27, 27, 27, 28, 28, 28, 28, 28, 28, 28, 28, 28, 28, 29, 29, 29, 29, 29, 29, 29, 29, 29, 29, 29, 29, 30, 30, 30, 30, 30, 30, 30, 30, 30, 30, 30, 30, 30, 30, 31, 31, 31, 31, 31, 31, 31, 31, 31, 31, 31, 31, 31, 31, 31};

__device__ __forceinline__ float bf2f(unsigned short b) { return __uint_as_float((unsigned)b << 16); }
__device__ __forceinline__ float wave_sum(float v) {
#pragma unroll
    for (int o = 1; o < 64; o <<= 1) v += __shfl_xor(v, o);
    return v;
}
__device__ __forceinline__ float wave_max(float v) {
#pragma unroll
    for (int o = 1; o < 64; o <<= 1) v = fmaxf(v, __shfl_xor(v, o));
    return v;
}
__device__ __forceinline__ float silu_f(float a) { return a / (1.0f + __expf(-a)); }
__device__ __forceinline__ float softplus_f(float v) { return fmaxf(v, 0.f) + log1pf(expf(-fabsf(v))); }

struct Frame {
    LAS unsigned char* lds;
    int tid, lane, wave, G, vcu;
    const float* in[22]; float* out; unsigned char* ws;
};

template <class RowMap>
__device__ __forceinline__ void p0_transpose_item(const float* W, int ldw, int nblk, const float* kscale, bf16* WT, int ldo, RowMap rm, LAS float* scr, int item, int lane) {
    const int kb = item / nblk, nb = item % nblk, k0 = 64 * kb, n0 = 32 * nb;
#pragma unroll 8
    for (int i = 0; i < 32; ++i) { const int kk = 2 * i + (lane >> 5); float v = W[(size_t)(k0 + kk) * ldw + n0 + (lane & 31)]; if (kscale) v *= kscale[k0 + kk]; scr[kk * 33 + (lane & 31)] = v; }
    LDS_WAIT(); asm volatile("" ::: "memory");
    const int c = lane & 7;
#pragma unroll
    for (int j = 0; j < 4; ++j) { const int n = (lane >> 3) + 8 * j; const LAS float* s = scr + (8 * c) * 33 + n;
        v4u o; o.x = pk2(s[0 * 33], s[1 * 33]); o.y = pk2(s[2 * 33], s[3 * 33]); o.z = pk2(s[4 * 33], s[5 * 33]); o.w = pk2(s[6 * 33], s[7 * 33]);
        *(GAS v4u*)(WT + (size_t)rm(n0 + n) * ldo + k0 + 8 * c) = o; }
    LDS_WAIT(); asm volatile("" ::: "memory");
}
struct RmId { __device__ __forceinline__ int operator()(int n) const { return n; } };
struct RmGU { int up; __device__ __forceinline__ int operator()(int n) const { return 8 * (n >> 2) + (n & 3) + 4 * up; } };

__device__ __forceinline__ void p0_prologue(Frame& F) {
    const float* x_p = F.in[0]; const float* x_s = F.in[1]; const float* norm1 = F.in[7]; const float* w_in = F.in[8]; const float* dt_bias = F.in[12];
    bf16* XN = (bf16*)(F.ws + WS_XN); float* DT = (float*)(F.ws + WS_DT);
    LAS float* wdt = (LAS float*)(F.lds);
    LAS float* scr = (LAS float*)(F.lds + 32768 + F.wave * 12288);
    for (int i = F.tid; i < 8192; i += NWAVES * 64) { const int k = i >> 3, j = i & 7; wdt[j * 1024 + k] = w_in[(size_t)k * LDW_IN + NPROJ + j]; }
    __syncthreads();
    const int gw = F.vcu * NWAVES + F.wave, NGW = F.G * NWAVES;
    constexpr int I_IN = 16 * 72, I_OUT = 16 * 32, I_G = 16 * 88, I_D = 44 * 32, NITEMS = I_IN + I_OUT + 2 * I_G + I_D;
    for (int it = gw; it < NITEMS; it += NGW) {
        int r = it;
        if (r < I_IN) { p0_transpose_item(F.in[8], LDW_IN, 72, (const float*)nullptr, (bf16*)(F.ws + WS_WIN), 1024, RmId{}, scr, r, F.lane); continue; } r -= I_IN;
        if (r < I_OUT) { p0_transpose_item(F.in[16], 1024, 32, (const float*)nullptr, (bf16*)(F.ws + WS_WOUT), 1024, RmId{}, scr, r, F.lane); continue; } r -= I_OUT;
        if (r < I_G) { p0_transpose_item(F.in[18], DFF, 88, F.in[17], (bf16*)(F.ws + WS_WGU), 1024, RmGU{0}, scr, r, F.lane); continue; } r -= I_G;
        if (r < I_G) { p0_transpose_item(F.in[19], DFF, 88, F.in[17], (bf16*)(F.ws + WS_WGU), 1024, RmGU{1}, scr, r, F.lane); continue; } r -= I_G;
        p0_transpose_item(F.in[20], 1024, 32, (const float*)nullptr, (bf16*)(F.ws + WS_WD), DFF, RmId{}, scr, r, F.lane);
    }
    f32x4 w1[4];
#pragma unroll
    for (int j = 0; j < 4; ++j) w1[j] = ((const f32x4*)norm1)[64 * j + F.lane];
    for (int m = gw; m < MP; m += NGW) {
        GAS unsigned long long* o8 = (GAS unsigned long long*)(XN + (size_t)m * DM) + F.lane;
        if (m >= MREAL) {
#pragma unroll
            for (int j = 0; j < 4; ++j) o8[64 * j] = 0ull;
            continue; }
        const float* xrow = m < MPROMPT ? x_p + (size_t)m * DM : x_s + (size_t)(m - MPROMPT) * DM;
        const f32x4* xr = (const f32x4*)xrow + F.lane;
        f32x4 v[4]; float s = 0.f;
#pragma unroll
        for (int j = 0; j < 4; ++j) { v[j] = xr[64 * j]; s += (v[j][0] * v[j][0] + v[j][1] * v[j][1]) + (v[j][2] * v[j][2] + v[j][3] * v[j][3]); }
        const float rstd = 1.0f / sqrtf(wave_sum(s) * (1.0f / DM) + EPS);
        float d[8];
#pragma unroll
        for (int q = 0; q < 8; ++q) d[q] = 0.f;
#pragma unroll
        for (int j = 0; j < 4; ++j) { v[j] = v[j] * w1[j] * rstd;
#pragma unroll
            for (int q = 0; q < 8; ++q) { const f32x4 wq = *(const LAS f32x4*)(wdt + q * 1024 + 256 * j + 4 * F.lane); d[q] += (v[j][0] * wq[0] + v[j][1] * wq[1]) + (v[j][2] * wq[2] + v[j][3] * wq[3]); } }
#pragma unroll
        for (int q = 0; q < 8; ++q) d[q] = wave_sum(d[q]);
        float dsel = d[0];
#pragma unroll
        for (int q = 1; q < 8; ++q) dsel = (F.lane == q) ? d[q] : dsel;
        if (F.lane < 8) DT[(size_t)m * 8 + F.lane] = softplus_f(dsel + dt_bias[F.lane]);
#pragma unroll
        for (int j = 0; j < 4; ++j) o8[64 * j] = (unsigned long long)pk2(v[j][0], v[j][1]) | ((unsigned long long)pk2(v[j][2], v[j][3]) << 32);
    }
    const int gt = F.vcu * NWAVES * 64 + F.tid, NGT = F.G * NWAVES * 64;
    for (int i = gt; i < NB * 4064; i += NGT) { const int b = i / 4064, r = i % 4064;
        ((f32x4*)(F.out + O_KS + (size_t)b * 16384))[r] = ((const f32x4*)(F.in[2] + (size_t)b * 16384 + 128))[r];
        ((f32x4*)(F.out + O_VS + (size_t)b * 16384))[r] = ((const f32x4*)(F.in[3] + (size_t)b * 16384 + 128))[r]; }
    for (int i = gt; i < NB * 512; i += NGT) { const int b = i / 512, r = i % 512;
        ((f32x4*)(F.out + O_CS + (size_t)b * 3072))[r] = ((const f32x4*)(F.in[4] + (size_t)b * 3072 + 1024))[r]; }
}

__device__ __forceinline__ void p2_conv_naive(Frame& F) {
    const bf16* PROJ = (const bf16*)(F.ws + WS_PROJ); bf16* XC = (bf16*)(F.ws + WS_XC);
    const float* sconv = F.in[4]; const float* cw = F.in[10]; const float* cb = F.in[11];
    const int gt = F.vcu * NWAVES * 64 + F.tid, NGT = F.G * NWAVES * 64;
    for (int i = gt; i < MREAL * 256; i += NGT) { const int m = i >> 8, ch = (i & 255) * 4;
        float a[4];
#pragma unroll
        for (int e = 0; e < 4; ++e) a[e] = cb[ch + e];
#pragma unroll
        for (int j = 0; j < 4; ++j) { float xv[4] = {0.f, 0.f, 0.f, 0.f};
            if (m < MPROMPT) { const int t = m & (SEQ - 1); if (t - 3 + j >= 0) { const unsigned long long q = *(const unsigned long long*)(PROJ + (size_t)(m - 3 + j) * NPROJ + C_XBC + ch);
#pragma unroll
                    for (int e = 0; e < 4; ++e) xv[e] = bf2f((unsigned short)(q >> (16 * e))); } }
            else { const int b = m - MPROMPT;
                if (j < 3) { const f32x4 q = *(const f32x4*)(sconv + (size_t)b * 3072 + j * 1024 + ch);
#pragma unroll
                    for (int e = 0; e < 4; ++e) xv[e] = q[e]; }
                else { const unsigned long long q = *(const unsigned long long*)(PROJ + (size_t)m * NPROJ + C_XBC + ch);
#pragma unroll
                    for (int e = 0; e < 4; ++e) xv[e] = bf2f((unsigned short)(q >> (16 * e))); } }
#pragma unroll
            for (int e = 0; e < 4; ++e) a[e] += cw[j * 1024 + ch + e] * xv[e]; }
        *(unsigned long long*)(XC + (size_t)m * 1024 + ch) = (unsigned long long)pk2(silu_f(a[0]), silu_f(a[1])) | ((unsigned long long)pk2(silu_f(a[2]), silu_f(a[3])) << 32);
    }
    for (int i = gt; i < BATCH * 128 * 128; i += NGT) { const int c = i & 127, j = (i >> 7) & 127, b = i >> 14; const size_t row = (size_t)b * SEQ + (SEQ - 128) + j;
        F.out[O_KP + i] = bf2f(PROJ[row * NPROJ + C_K + c]); F.out[O_VP + i] = bf2f(PROJ[row * NPROJ + C_V + c]); }
    for (int i = gt; i < BATCH * 3 * 1024; i += NGT) { const int c = i & 1023, j = (i >> 10) % 3, b = i / 3072; F.out[O_CP + i] = bf2f(PROJ[((size_t)b * SEQ + SEQ - 3 + j) * NPROJ + C_XBC + c]); }
    for (int i = gt; i < NB * 128; i += NGT) { const int c = i & 127, b = i >> 7; const size_t row = MPROMPT + b;
        F.out[O_KS + (size_t)b * 16384 + 127 * 128 + c] = bf2f(PROJ[row * NPROJ + C_K + c]); F.out[O_VS + (size_t)b * 16384 + 127 * 128 + c] = bf2f(PROJ[row * NPROJ + C_V + c]); }
    for (int i = gt; i < NB * 1024; i += NGT) { const int c = i & 1023, b = i >> 10; F.out[O_CS + (size_t)b * 3072 + 2048 + c] = bf2f(PROJ[(size_t)(MPROMPT + b) * NPROJ + C_XBC + c]); }
}
__device__ __forceinline__ void p3_attn_naive(Frame& F, int m_lo) {
    const bf16* PROJ = (const bf16*)(F.ws + WS_PROJ); bf16* MIX = (bf16*)(F.ws + WS_MIX);
    const float* ck = F.in[2]; const float* cv = F.in[3]; const float* relb = F.in[6]; const float* sinks = F.in[9];
    const int gw = F.vcu * NWAVES + F.wave, NGW = F.G * NWAVES, lane = F.lane;
    for (int task = m_lo * 8 + gw; task < MREAL * 8; task += NGW) { const int m = task >> 3, hh = task & 7, kvh = hh >> 2;
        const bool prompt = m < MPROMPT; const int t = m & (SEQ - 1), b = prompt ? (m >> 12) : (m - MPROMPT);
        float q[64];
        { const bf16* qp = PROJ + (size_t)m * NPROJ + C_Q + hh * 64;
#pragma unroll
          for (int d8 = 0; d8 < 8; ++d8) { const v4u w = *(const v4u*)(qp + d8 * 8);
#pragma unroll
              for (int e = 0; e < 4; ++e) { q[d8 * 8 + 2 * e] = __uint_as_float(w[e] << 16); q[d8 * 8 + 2 * e + 1] = __uint_as_float(w[e] & 0xffff0000u); } } }
        float s[2];
#pragma unroll
        for (int half = 0; half < 2; ++half) { const int i = lane + 64 * half; float acc = 0.f; bool valid = true;
            if (prompt) { const int kt = t - 127 + i; valid = kt >= 0;
                if (valid) { const bf16* kp = PROJ + (size_t)(m - 127 + i) * NPROJ + C_K + kvh * 64;
#pragma unroll
                    for (int d8 = 0; d8 < 8; ++d8) { const v4u w = *(const v4u*)(kp + d8 * 8);
#pragma unroll
                        for (int e = 0; e < 4; ++e) acc += q[d8 * 8 + 2 * e] * __uint_as_float(w[e] << 16) + q[d8 * 8 + 2 * e + 1] * __uint_as_float(w[e] & 0xffff0000u); } } }
            else if (i < 127) { const float* kp = ck + ((size_t)b * 128 + i + 1) * 128 + kvh * 64;
#pragma unroll
                for (int d4 = 0; d4 < 16; ++d4) { const f32x4 w = *(const f32x4*)(kp + d4 * 4); acc += (q[d4 * 4] * w[0] + q[d4 * 4 + 1] * w[1]) + (q[d4 * 4 + 2] * w[2] + q[d4 * 4 + 3] * w[3]); } }
            else { const bf16* kp = PROJ + (size_t)m * NPROJ + C_K + kvh * 64;
#pragma unroll
                for (int d8 = 0; d8 < 8; ++d8) { const v4u w = *(const v4u*)(kp + d8 * 8);
#pragma unroll
                    for (int e = 0; e < 4; ++e) acc += q[d8 * 8 + 2 * e] * __uint_as_float(w[e] << 16) + q[d8 * 8 + 2 * e + 1] * __uint_as_float(w[e] & 0xffff0000u); } }
            s[half] = valid ? acc * 0.125f + relb[BUCKET[127 - i] * 8 + hh] : -INFINITY; }
        const float sk = sinks[hh];
        const float mx = fmaxf(wave_max(fmaxf(s[0], s[1])), sk);
        float p0 = __expf(s[0] - mx), p1 = __expf(s[1] - mx);
        const float den = wave_sum(p0 + p1) + __expf(sk - mx), inv = 1.0f / den;
        p0 *= inv; p1 *= inv;
        float o = 0.f;
        for (int i = 0; i < 128; ++i) { const float p = __shfl(i < 64 ? p0 : p1, i & 63);
            float v = 0.f;
            if (prompt) { if (t - 127 + i >= 0) v = bf2f(PROJ[(size_t)(m - 127 + i) * NPROJ + C_V + kvh * 64 + lane]); }
            else if (i < 127) v = cv[((size_t)b * 128 + i + 1) * 128 + kvh * 64 + lane];
            else v = bf2f(PROJ[(size_t)m * NPROJ + C_V + kvh * 64 + lane]);
            o += p * v; }
        MIX[(size_t)m * 1024 + hh * 64 + lane] = (bf16)f2bf(o);
    }
}
__device__ __forceinline__ void p3_ssm_naive(Frame& F) {
    const bf16* XC = (const bf16*)(F.ws + WS_XC); const float* DT = (const float*)(F.ws + WS_DT); float* YS = (float*)(F.ws + WS_YS);
    const float* A_log = F.in[13]; const float* Dsk = F.in[14]; const float* st0 = F.in[5];
    const int gw = F.vcu * NWAVES + F.wave, NGW = F.G * NWAVES, lane = F.lane;
    for (int task = gw; task < BATCH * 8 * 64; task += NGW) { const int p = task & 63, hd = (task >> 6) & 7, b = task >> 9, g = hd >> 2;
        const float A = -expf(A_log[hd]), Dv = Dsk[hd]; float h0 = 0.f, h1 = 0.f;
        for (int t = 0; t < SEQ; ++t) { const size_t m = (size_t)b * SEQ + t;
            const float dt = DT[m * 8 + hd], x = bf2f(XC[m * 1024 + hd * 64 + p]);
            const unsigned bw = *(const unsigned*)(XC + m * 1024 + 512 + g * 128 + 2 * lane), cw = *(const unsigned*)(XC + m * 1024 + 768 + g * 128 + 2 * lane);
            const float dA = expf(dt * A), dx = dt * x;
            h0 = h0 * dA + dx * __uint_as_float(bw << 16); h1 = h1 * dA + dx * __uint_as_float(bw & 0xffff0000u);
            const float y = wave_sum(__uint_as_float(cw << 16) * h0 + __uint_as_float(cw & 0xffff0000u) * h1);
            if (lane == 0) YS[m * 512 + hd * 64 + p] = y + Dv * x; }
        F.out[O_SP + ((size_t)((b * 8 + hd) * 64 + p)) * 128 + 2 * lane] = h0; F.out[O_SP + ((size_t)((b * 8 + hd) * 64 + p)) * 128 + 2 * lane + 1] = h1;
    }
    for (int task = gw; task < NB * 8 * 64; task += NGW) { const int p = task & 63, hd = (task >> 6) & 7, b = task >> 9, g = hd >> 2; const size_t m = MPROMPT + b;
        const float A = -expf(A_log[hd]), Dv = Dsk[hd]; const size_t so = ((size_t)((b * 8 + hd) * 64 + p)) * 128 + 2 * lane;
        float h0 = st0[so], h1 = st0[so + 1];
        const float dt = DT[m * 8 + hd], x = bf2f(XC[m * 1024 + hd * 64 + p]);
        const unsigned bw = *(const unsigned*)(XC + m * 1024 + 512 + g * 128 + 2 * lane), cw = *(const unsigned*)(XC + m * 1024 + 768 + g * 128 + 2 * lane);
        const float dA = expf(dt * A), dx = dt * x;
        h0 = h0 * dA + dx * __uint_as_float(bw << 16); h1 = h1 * dA + dx * __uint_as_float(bw & 0xffff0000u);
        const float y = wave_sum(__uint_as_float(cw << 16) * h0 + __uint_as_float(cw & 0xffff0000u) * h1);
        if (lane == 0) YS[m * 512 + hd * 64 + p] = y + Dv * x;
        F.out[O_SS + so] = h0; F.out[O_SS + so + 1] = h1;
    }
}
__device__ __forceinline__ void p4_gate_naive(Frame& F) {
    const bf16* PROJ = (const bf16*)(F.ws + WS_PROJ); bf16* MIX = (bf16*)(F.ws + WS_MIX); const float* YS = (const float*)(F.ws + WS_YS); const float* nw = F.in[15];
    const int gw = F.vcu * NWAVES + F.wave, NGW = F.G * NWAVES, lane = F.lane;
    for (int task = gw; task < MREAL * 2; task += NGW) { const int m = task >> 1, ch = (task & 1) * 256 + 4 * lane;
        const f32x4 y = *(const f32x4*)(YS + (size_t)m * 512 + ch); const unsigned long long zq = *(const unsigned long long*)(PROJ + (size_t)m * NPROJ + C_Z + ch);
        float v[4]; float s = 0.f;
#pragma unroll
        for (int e = 0; e < 4; ++e) { v[e] = y[e] * silu_f(bf2f((unsigned short)(zq >> (16 * e)))); s += v[e] * v[e]; }
        const float rstd = 1.0f / sqrtf(wave_sum(s) * (1.0f / 256.0f) + EPS); const f32x4 w = *(const f32x4*)(nw + ch);
        *(unsigned long long*)(MIX + (size_t)m * 1024 + 512 + ch) = (unsigned long long)pk2(v[0] * rstd * w[0], v[1] * rstd * w[1]) | ((unsigned long long)pk2(v[2] * rstd * w[2], v[3] * rstd * w[3]) << 32);
    }
}
typedef float f32x16 __attribute__((ext_vector_type(16)));
typedef unsigned long long u64;
__device__ __forceinline__ int crow(int r, int h) { return (r & 3) + 8 * (r >> 2) + 4 * h; }
__device__ __forceinline__ bf16x8 pack8(float a0, float a1, float a2, float a3, float a4, float a5, float a6, float a7) {
    v4u w; w.x = pk2(a0, a1); w.y = pk2(a2, a3); w.z = pk2(a4, a5); w.w = pk2(a6, a7); return __builtin_bit_cast(bf16x8, w);
}
constexpr int AT_KP = 144, AT_VP = 520;
constexpr int AT_K = 0, AT_V = 256 * AT_KP, AT_BIAS = AT_V + 64 * AT_VP, AT_LW = AT_BIAS + 3072, AT_END = AT_LW + 1024;
__device__ __forceinline__ void attn_unit(Frame& F, int b, int nblk, int kvh) {
    const bf16* PROJ = (const bf16*)(F.ws + WS_PROJ); bf16* MIX = (bf16*)(F.ws + WS_MIX);
    const float* relb = F.in[6]; const float* sinks = F.in[9];
    LAS unsigned char* L = F.lds;
    LAS float* BIASL = (LAS float*)(L + AT_BIAS); LAS float* LW = (LAS float*)(L + AT_LW);
    const int tid = F.tid, lane = F.lane, wave = F.wave, r32 = lane & 31, h = lane >> 5;
    constexpr float LOG2E = 1.4426950408889634f;
    { const int row = tid & 255; const int trow = (nblk - 1) * 128 + row; const bool ok = trow >= 0;
      const bf16* src = PROJ + (size_t)(b * SEQ + (ok ? trow : 0)) * NPROJ + kvh * 64;
#pragma unroll
      for (int k = 0; k < 4; ++k) { const int c16 = 2 * k + (tid >> 8);
          v4u kq = ok ? *(const v4u*)(src + C_K + c16 * 8) : (v4u){0u, 0u, 0u, 0u};
          v4u vq = ok ? *(const v4u*)(src + C_V + c16 * 8) : (v4u){0u, 0u, 0u, 0u};
          *(LAS v4u*)(L + AT_K + row * AT_KP + c16 * 16) = kq;
#pragma unroll
          for (int e = 0; e < 8; ++e) *(LAS unsigned short*)(L + AT_V + (c16 * 8 + e) * AT_VP + row * 2) = (unsigned short)(vq[e >> 1] >> (16 * (e & 1))); }
      for (int i = tid; i < 768; i += NWAVES * 64) { const int rr = i / 192, d = i % 192 - 32;
          BIASL[i] = (d >= 0 && d < 128) ? relb[BUCKET[d & 127] * 8 + kvh * 4 + rr] * LOG2E : 0.f; } }
    __syncthreads();
    const int r = wave >> 1, half = wave & 1, hh = kvh * 4 + r;
    const float sink2 = sinks[hh] * LOG2E;
#pragma unroll 1
    for (int qq = 0; qq < 2; ++qq) {
        const int q0 = half * 64 + qq * 32;
        const size_t mq = (size_t)b * SEQ + nblk * 128 + q0;
        bf16x8 qf[4];
#pragma unroll
        for (int ks = 0; ks < 4; ++ks) qf[ks] = *(const bf16x8*)(PROJ + (mq + r32) * NPROJ + C_Q + hh * 64 + ks * 16 + h * 8);
        f32x16 st[5];
#pragma unroll
        for (int kk = 0; kk < 5; ++kk) { st[kk] = (f32x16){0.f, 0.f, 0.f, 0.f, 0.f, 0.f, 0.f, 0.f, 0.f, 0.f, 0.f, 0.f, 0.f, 0.f, 0.f, 0.f};
            const LAS unsigned char* kp = L + AT_K + (q0 + kk * 32 + r32) * AT_KP + h * 16;
#pragma unroll
            for (int ks = 0; ks < 4; ++ks) { const bf16x8 kf = *(const LAS bf16x8*)(kp + ks * 32); st[kk] = __builtin_amdgcn_mfma_f32_32x32x16_bf16(kf, qf[ks], st[kk], 0, 0, 0); }
            __builtin_amdgcn_sched_barrier(0); }
        float mx = -INFINITY; const LAS float* bl = BIASL + r * 192 + 32 + r32 + 128 - 4 * h;
#pragma unroll
        for (int kk = 0; kk < 5; ++kk)
#pragma unroll
            for (int reg = 0; reg < 16; ++reg) { const int krel = kk * 32 + crow(reg, h);
                const int dist = r32 + 128 - krel; const int kj = q0 + krel;
                const bool valid = dist >= 0 && dist < 128 && (nblk > 0 || kj >= 128);
                const float s = valid ? st[kk][reg] * (0.125f * LOG2E) + bl[-(kk * 32 + (reg & 3) + 8 * (reg >> 2))] : -INFINITY;
                st[kk][reg] = s; mx = fmaxf(mx, s); }
        mx = fmaxf(mx, __shfl_xor(mx, 32)); mx = fmaxf(mx, sink2);
        float l = 0.f;
#pragma unroll
        for (int kk = 0; kk < 5; ++kk)
#pragma unroll
            for (int reg = 0; reg < 16; ++reg) { const float p = __builtin_amdgcn_exp2f(st[kk][reg] - mx); st[kk][reg] = p; l += p; }
        l += __shfl_xor(l, 32); l += __builtin_amdgcn_exp2f(sink2 - mx);
        if (h == 0) LW[wave * 32 + r32] = 1.0f / l;
        f32x16 o[2];
        o[0] = (f32x16){0.f, 0.f, 0.f, 0.f, 0.f, 0.f, 0.f, 0.f, 0.f, 0.f, 0.f, 0.f, 0.f, 0.f, 0.f, 0.f}; o[1] = o[0];
#pragma unroll
        for (int kk = 0; kk < 5; ++kk)
#pragma unroll
            for (int s = 0; s < 2; ++s) { const bf16x8 pf = pack8(st[kk][8 * s], st[kk][8 * s + 1], st[kk][8 * s + 2], st[kk][8 * s + 3], st[kk][8 * s + 4], st[kk][8 * s + 5], st[kk][8 * s + 6], st[kk][8 * s + 7]);
#pragma unroll
                for (int db = 0; db < 2; ++db) { const LAS unsigned char* vp = L + AT_V + (db * 32 + r32) * AT_VP + (q0 + kk * 32 + 16 * s + 4 * h) * 2;
                    const u64 lo = *(const LAS u64*)vp, hi = *(const LAS u64*)(vp + 16);
                    typedef u64 u64x2 __attribute__((ext_vector_type(2))); const u64x2 vv = {lo, hi};
                    o[db] = __builtin_amdgcn_mfma_f32_32x32x16_bf16(pf, __builtin_bit_cast(bf16x8, vv), o[db], 0, 0, 0); }
                __builtin_amdgcn_sched_barrier(0); }
        LDS_WAIT();
#pragma unroll
        for (int reg = 0; reg < 16; ++reg) { const int qi = crow(reg, h); const float inv = LW[wave * 32 + qi];
#pragma unroll
            for (int db = 0; db < 2; ++db) MIX[(mq + qi) * 1024 + hh * 64 + db * 32 + r32] = (bf16)f2bf(o[db][reg] * inv); }
    }
    __syncthreads();
}
__device__ __forceinline__ void p8_final_norm(Frame& F) {
    const float* wf = F.in[21];
    const int gw = F.vcu * NWAVES + F.wave, NGW = F.G * NWAVES;
    f32x4 w[4];
#pragma unroll
    for (int j = 0; j < 4; ++j) w[j] = ((const f32x4*)wf)[64 * j + F.lane];
    for (int m = gw; m < MREAL; m += NGW) { f32x4* xr = (f32x4*)(F.out + (size_t)m * DM) + F.lane; f32x4 v[4]; float s = 0.f;
#pragma unroll
        for (int j = 0; j < 4; ++j) { v[j] = xr[64 * j]; s += (v[j][0] * v[j][0] + v[j][1] * v[j][1]) + (v[j][2] * v[j][2] + v[j][3] * v[j][3]); }
        const float rstd = 1.0f / sqrtf(wave_sum(s) * (1.0f / DM) + EPS);
#pragma unroll
        for (int j = 0; j < 4; ++j) xr[64 * j] = v[j] * rstd * w[j]; }
}

struct Args { const float* in[22]; float* out; unsigned char* ws; int ph_lo, ph_hi; };
constexpr int N_PHASES = 9;
#ifndef MK_ONE_LAUNCH
#define MK_ONE_LAUNCH 1
#endif
__global__ void __launch_bounds__(NWAVES * 64, 2) hymba_fwd(Args args) {
    extern __shared__ __attribute__((aligned(16))) unsigned char lds[];
    Frame F;
    F.lds = (LAS unsigned char*)lds;
    F.tid = threadIdx.x; F.lane = F.tid & 63; F.wave = __builtin_amdgcn_readfirstlane(F.tid >> 6);
    F.G = gridDim.x; { const int bx = blockIdx.x; F.vcu = (F.G % 8 == 0) ? (bx % 8) * (F.G / 8) + bx / 8 : bx; }
#pragma unroll
    for (int i = 0; i < 22; ++i) F.in[i] = args.in[i];
    F.out = args.out; F.ws = args.ws;
    volatile LAS unsigned* MISC = (volatile LAS unsigned*)(F.lds + MISC_OFF);
    if (F.tid < 64) MISC[F.tid] = 0u;
    __syncthreads();
    gu32* ctl = (gu32*)(F.ws + WS_CTL);
    XcdBarrier bar; bar.bar = (unsigned*)(ctl + CW_BAR); bar.x = 0; bar.st = nullptr;
    const int lo = args.ph_lo, hi = args.ph_hi;
    if (hi - lo > 1) bar = xcd_barrier_post((unsigned*)(ctl + CW_BAR), MISC + 8);
#define IN(k) (lo <= (k) && (k) < hi)
#define SEAM(k) do { if (IN(k) && IN((k) + 1)) xcd_barrier(bar); } while (0)
    bf16* XN = (bf16*)(F.ws + WS_XN); bf16* PROJ = (bf16*)(F.ws + WS_PROJ); bf16* MIX = (bf16*)(F.ws + WS_MIX); bf16* HB = (bf16*)(F.ws + WS_PROJ);
    float* SSQ1 = (float*)(F.ws + WS_SSQ1);
    if (IN(0)) { p0_prologue(F); SEAM(0); }
    if (IN(1)) {
        pg8::Gemm g{XN, (const bf16*)(F.ws + WS_WIN), MP, NPROJ, DM}; pg8::StaticOrder S; S.init(MP, NPROJ, F.G, (int)blockIdx.x);
        pg8::EpiStoreBf16 E{PROJ, NPROJ};
        pg8::gemm_phase<pg8::EpiStoreBf16, pg8::StaticOrder, true, true>(F.lds + RING_OFF, g, S, E);
        SEAM(1);
    }
    if (IN(2)) { p2_conv_naive(F); SEAM(2); }
    if (IN(3)) { p3_ssm_naive(F); p3_attn_naive(F, MPROMPT); for (int u = F.vcu; u < 256; u += F.G) attn_unit(F, u >> 6, (u >> 1) & 31, u & 1); SEAM(3); }
    if (IN(4)) { p4_gate_naive(F); SEAM(4); }
    if (IN(5)) {
        pg8::Gemm g{MIX, (const bf16*)(F.ws + WS_WOUT), MP, DM, DM}; pg8::StaticOrder S; S.init(MP, DM, F.G, (int)blockIdx.x);
        pg8::EpiResid E{F.in[0], F.in[1], MPROMPT, F.out, XN, SSQ1, MREAL};
        pg8::gemm_phase<pg8::EpiResid, pg8::StaticOrder, true, true>(F.lds + RING_OFF, g, S, E);
        SEAM(5);
    }
    if (IN(6)) {
        pg8::Gemm g{XN, (const bf16*)(F.ws + WS_WGU), MP, NGU, DM}; pg8::StaticOrder S; S.init(MP, NGU, F.G, (int)blockIdx.x);
        pg8::EpiSwiglu E{HB, DFF, SSQ1, EPS};
        pg8::gemm_phase<pg8::EpiSwiglu, pg8::StaticOrder, true, true>(F.lds + RING_OFF, g, S, E);
        SEAM(6);
    }
    if (IN(7)) {
        pg8::Gemm g{HB, (const bf16*)(F.ws + WS_WD), MP, DM, DFF}; pg8::StaticOrder S; S.init(MP, DM, F.G, (int)blockIdx.x);
        pg8::EpiResid E{F.out, F.out, MP, F.out, nullptr, nullptr, MREAL};
        pg8::gemm_phase<pg8::EpiResid, pg8::StaticOrder, true, true>(F.lds + RING_OFF, g, S, E);
        SEAM(7);
    }
    if (IN(8)) { p8_final_norm(F); }
#undef IN
#undef SEAM
}

extern "C" void kernel_launch(void* const* d_in, const int* in_sizes, int n_in, void* d_out, int out_size, void* d_ws, size_t ws_size, hipStream_t stream) {
    static int grid = 0;
    if (grid == 0) {
        if (n_in != 22 || (size_t)out_size != O_END || ws_size < WS_END) { fprintf(stderr, "kernel_launch: unexpected shapes (n_in %d out %d ws %zu)\n", n_in, out_size, ws_size); grid = -1; return; }
        int dev = 0, cus = 0;
        if (hipGetDevice(&dev) != hipSuccess || hipDeviceGetAttribute(&cus, hipDeviceAttributeMultiprocessorCount, dev) != hipSuccess) { grid = -1; return; }
        if (hipFuncSetAttribute((const void*)hymba_fwd, hipFuncAttributeMaxDynamicSharedMemorySize, LDS_BYTES) != hipSuccess) { fprintf(stderr, "kernel_launch: hipFuncSetAttribute failed\n"); grid = -1; return; }
        int per_cu = 0;
        if (hipOccupancyMaxActiveBlocksPerMultiprocessor(&per_cu, (const void*)hymba_fwd, NWAVES * 64, LDS_BYTES) != hipSuccess || per_cu < 1) fprintf(stderr, "kernel_launch: occupancy query reports %d\n", per_cu);
        (void)hipGetLastError();
        grid = cus;
    }
    if (grid < 0) return;
    if (hipMemsetAsync((char*)d_ws + WS_CTL, 0, CTL_ZERO_BYTES, stream) != hipSuccess) return;
    Args a{};
    for (int i = 0; i < 22; ++i) a.in[i] = (const float*)d_in[i];
    a.out = (float*)d_out; a.ws = (unsigned char*)d_ws;
#if MK_ONE_LAUNCH
    a.ph_lo = 0; a.ph_hi = N_PHASES;
    hipLaunchKernelGGL(hymba_fwd, dim3(grid), dim3(NWAVES * 64), LDS_BYTES, stream, a);
#else
    for (int p = 0; p < N_PHASES; ++p) { a.ph_lo = p; a.ph_hi = p + 1; hipLaunchKernelGGL(hymba_fwd, dim3(grid), dim3(NWAVES * 64), LDS_BYTES, stream, a); }
#endif
}
```

```cpp
#include <hip/hip_runtime.h>
#include <cstdio>
#include <cstdint>
namespace pg8 {
#define PG8_LAS __attribute__((address_space(3)))
typedef unsigned short bf16_t;
typedef short bf16x8 __attribute__((ext_vector_type(8)));
typedef float f32x4 __attribute__((ext_vector_type(4)));
typedef unsigned u32x4 __attribute__((ext_vector_type(4)));
constexpr int BM = 256, BK = 64, HALF = 128, HTB = HALF * BK * 2  , STAGE_BYTES = 8 * HTB, NXCD = 8, WGM = 8;

__host__ __device__ __forceinline__ int lds_byte(int r, int c) { const int st = (r >> 4) * 2 + (c >> 5), rr = r & 15, cc = c & 31, ob = rr * 64 + cc * 2; return st * 1024 + (ob ^ (((ob >> 9) & 1) << 5)); }
__host__ __device__ __forceinline__ void stage_rc(int b, int& R, int& C) { const int st = b / 1024, sb = b % 1024, swz = sb ^ (((sb >> 9) & 1) << 5); R = (st >> 1) * 16 + swz / 64; C = (st & 1) * 32 + (swz % 64) / 2; }
__host__ __device__ __forceinline__ int perm32(int rho) { const int n = rho >> 4, i = rho & 15; return 8 * (i >> 2) + 4 * n + (i & 3); }

struct Unit { int pm, pn; };
struct Gemm { const bf16_t* A; const bf16_t* Bt; int M, N, K; };

struct StaticOrder {
    int nM, nN, nwg, G, c;
    __host__ __device__ void init(int M, int N, int G_, int c_) { nM = M / BM; nN = N / BM; nwg = nM * nN; G = G_; c = c_; }
    __host__ __device__ bool next(int i, Unit& u) const {
        const long L = (long)i * G + c; if (L >= nwg) return false;
        int wgid = (int)L; { const int q = nwg / NXCD, r = nwg % NXCD, xcd = wgid % NXCD, off = wgid / NXCD; wgid = (xcd < r ? xcd * (q + 1) : r * (q + 1) + (xcd - r) * q) + off; }
        const int nig = WGM * nN, gid = wgid / nig, fm = gid * WGM, gsz = (nM - fm) < WGM ? (nM - fm) : WGM;
        u.pm = fm + ((wgid % nig) % gsz); u.pn = (wgid % nig) / gsz; return true;
    }
    __device__ __forceinline__ void a_ready(const Unit&) const {}
    __device__ __forceinline__ void done(const Unit&) const {}
};

__device__ __forceinline__ unsigned cvt_pk_bf16(float lo, float hi) { unsigned r; asm volatile("v_cvt_pk_bf16_f32 %0, %1, %2" : "=v"(r) : "v"(lo), "v"(hi)); return r; }
typedef unsigned u32x2 __attribute__((ext_vector_type(2)));
struct EpiStoreBf16 {
    static constexpr bool PERM = true, AFTER_DRAIN = false;
    bf16_t* O; int ldc;
    __device__ __forceinline__ void operator()(const f32x4 (&acc)[2][2][4][2], const Unit& u, int wr, int wc, int fr, int fq) const {
        const int row0 = u.pm * BM + wr * 64 + fr, col0 = u.pn * BM + wc * 32 + 8 * fq;
#pragma unroll
        for (int ai = 0; ai < 2; ++ai)
#pragma unroll
            for (int m = 0; m < 4; ++m) { bf16_t* rowp = O + (size_t)(row0 + ai * HALF + m * 16) * ldc + col0;
#pragma unroll
                for (int bj = 0; bj < 2; ++bj) { const f32x4 v0 = acc[ai][bj][m][0], v1 = acc[ai][bj][m][1];
                    u32x4 w; w.x = cvt_pk_bf16(v0[0], v0[1]); w.y = cvt_pk_bf16(v0[2], v0[3]); w.z = cvt_pk_bf16(v1[0], v1[1]); w.w = cvt_pk_bf16(v1[2], v1[3]);
                    *(u32x4*)(rowp + bj * HALF) = w; } }
    }
};
struct EpiResid {
    static constexpr bool PERM = false, AFTER_DRAIN = false;
    const float* base0; const float* base1; int split; float* out; bf16_t* xb; float* ssq; int mreal;
    __device__ __forceinline__ void operator()(const f32x4 (&acc)[2][2][4][2], const Unit& u, int wr, int wc, int fr, int fq) const {
        const int col0 = u.pn * BM + wc * 32 + 4 * fq;
#pragma unroll
        for (int ai = 0; ai < 2; ++ai)
#pragma unroll
            for (int m = 0; m < 4; ++m) { const int row = u.pm * BM + ai * HALF + wr * 64 + m * 16 + fr;
                float s = 0.f;
                if (row < mreal) {
                    const float* bp = (row < split ? base0 + (size_t)row * 1024 : base1 + (size_t)(row - split) * 1024) + col0;
                    float* op = out + (size_t)row * 1024 + col0;
#pragma unroll
                    for (int bj = 0; bj < 2; ++bj)
#pragma unroll
                        for (int n = 0; n < 2; ++n) { const f32x4 v = *(const f32x4*)(bp + bj * HALF + n * 16) + acc[ai][bj][m][n];
                            *(f32x4*)(op + bj * HALF + n * 16) = v; s += (v[0] * v[0] + v[1] * v[1]) + (v[2] * v[2] + v[3] * v[3]);
                            if (xb) { u32x2 w; w.x = cvt_pk_bf16(v[0], v[1]); w.y = cvt_pk_bf16(v[2], v[3]); *(u32x2*)(xb + (size_t)row * 1024 + col0 + bj * HALF + n * 16) = w; } }
                }
                if (ssq) { s += __shfl_xor(s, 16); s += __shfl_xor(s, 32); if (fq == 0 && row < mreal) ssq[(size_t)row * 16 + u.pn * 4 + wc] = s; }
            }
    }
};
struct EpiSwiglu {
    static constexpr bool PERM = true, AFTER_DRAIN = false;
    bf16_t* H; int ldh; const float* ssq; float eps;
    __device__ __forceinline__ void operator()(const f32x4 (&acc)[2][2][4][2], const Unit& u, int wr, int wc, int fr, int fq) const {
        const int row0 = u.pm * BM + wr * 64 + fr, hcol0 = (u.pn * BM + wc * 32 + 8 * fq) >> 1;
#pragma unroll
        for (int ai = 0; ai < 2; ++ai)
#pragma unroll
            for (int m = 0; m < 4; ++m) { const int row = row0 + ai * HALF + m * 16;
                const f32x4* sp = (const f32x4*)(ssq + (size_t)row * 16); const f32x4 s0 = sp[0], s1 = sp[1], s2 = sp[2], s3 = sp[3];
                const float sum = ((s0[0] + s0[1]) + (s0[2] + s0[3])) + ((s1[0] + s1[1]) + (s1[2] + s1[3])) + ((s2[0] + s2[1]) + (s2[2] + s2[3])) + ((s3[0] + s3[1]) + (s3[2] + s3[3]));
                const float rstd = 1.0f / sqrtf(sum * (1.0f / 1024.0f) + eps);
#pragma unroll
                for (int bj = 0; bj < 2; ++bj) { const f32x4 g = acc[ai][bj][m][0] * rstd, up = acc[ai][bj][m][1] * rstd; float hv[4];
#pragma unroll
                    for (int e = 0; e < 4; ++e) hv[e] = g[e] * __builtin_amdgcn_rcpf(1.0f + __expf(-g[e])) * up[e];
                    u32x2 w; w.x = cvt_pk_bf16(hv[0], hv[1]); w.y = cvt_pk_bf16(hv[2], hv[3]);
                    *(u32x2*)(H + (size_t)row * ldh + hcol0 + bj * (HALF / 2)) = w; } }
    }
};
template <class Epi, class Sched, bool ALIGN_EPI = false, bool SP2 = false>
__device__ __forceinline__ void gemm_phase(PG8_LAS unsigned char* lds, const Gemm g, const Sched& S, const Epi& E) {
    const int tid = threadIdx.x, wid = __builtin_amdgcn_readfirstlane(tid >> 6), lane = tid & 63, wr = wid >> 2, wc = wid & 3, fr = lane & 15, fq = lane >> 4;
    const int K = g.K, nt = K / BK;
    unsigned voffA[2], voffB[2];
#pragma unroll
    for (int i = 0; i < 2; ++i) { int R, C; stage_rc(tid * 16 + i * 8192, R, C); const int Rb = Epi::PERM ? ((R & ~31) + perm32(R & 31)) : R;
        voffA[i] = (unsigned)(R * K + C) * 2u; voffB[i] = (unsigned)(Rb * K + C) * 2u; }
    const size_t kstep = (size_t)(BK * 2);
    const size_t hstep = (size_t)HALF * K * 2;
    const size_t tstep = 2 * hstep;
    const unsigned ldsw = (unsigned)wid * 1024u;
    const int aoff = lds_byte(wr * 64 + fr, fq * 8), boff = lds_byte(wc * 32 + fr, fq * 8);
#define PG8_SA(b, h) (((b) * 2 + (h)) * HTB)
#define PG8_SB(b, h) ((4 + (b) * 2 + (h)) * HTB)
#define PG8_STAGE(bufoff, gbase, voff) do { _Pragma("unroll") for (int _i = 0; _i < 2; ++_i) \
        __builtin_amdgcn_global_load_lds((const unsigned*)((const char*)(gbase) + (voff)[_i]), (PG8_LAS unsigned*)(lds + (bufoff) + ldsw + _i * 8192), 16, 0, 0); } while (0)
#define PG8_LDA(dst, b, h) do { _Pragma("unroll") for (int m = 0; m < 4; ++m) _Pragma("unroll") for (int k = 0; k < 2; ++k) dst[m][k] = *(const PG8_LAS bf16x8*)(lds + PG8_SA(b, h) + aoff + m * 2048 + k * 1024); } while (0)
#define PG8_LDB(dst, b, h) do { _Pragma("unroll") for (int n = 0; n < 2; ++n) _Pragma("unroll") for (int k = 0; k < 2; ++k) dst[n][k] = *(const PG8_LAS bf16x8*)(lds + PG8_SB(b, h) + boff + n * 2048 + k * 1024); } while (0)
#define PG8_MMA(ai, bj, At, Bt) do { __builtin_amdgcn_s_setprio(1); _Pragma("unroll") for (int m = 0; m < 4; ++m) _Pragma("unroll") for (int n = 0; n < 2; ++n) _Pragma("unroll") for (int k = 0; k < 2; ++k) \
        acc[ai][bj][m][n] = __builtin_amdgcn_mfma_f32_16x16x32_bf16(Bt[n][k], At[m][k], acc[ai][bj][m][n], 0, 0, 0); __builtin_amdgcn_s_setprio(0); } while (0)
#define PG8_WAIT_V(n) asm volatile("s_waitcnt vmcnt(" #n ")" ::: "memory")
#define PG8_WAIT_L(n) asm volatile("s_waitcnt lgkmcnt(" #n ")" ::: "memory")
#define PG8_BAR __builtin_amdgcn_s_barrier()
#define PG8_SCHED __builtin_amdgcn_sched_barrier(0)
    Unit cur, nxt; int ui = 0;
    if (!S.next(0, cur)) return;
    f32x4 acc[2][2][4][2];
#pragma unroll
    for (int a = 0; a < 2; ++a)
#pragma unroll
        for (int b = 0; b < 2; ++b)
#pragma unroll
            for (int m = 0; m < 4; ++m)
#pragma unroll
                for (int n = 0; n < 2; ++n) acc[a][b][m][n] = (f32x4){0.f, 0.f, 0.f, 0.f};
    bf16x8 At[4][2], B0[2][2], B1[2][2];
    const char* cA = (const char*)g.A + (size_t)cur.pm * tstep; const char* cB = (const char*)g.Bt + (size_t)cur.pn * tstep;
    S.a_ready(cur);
    if constexpr (SP2) {
        PG8_STAGE(PG8_SB(0, 0), cB, voffB); PG8_STAGE(PG8_SB(0, 1), cB + hstep, voffB); PG8_STAGE(PG8_SA(0, 0), cA, voffA); PG8_STAGE(PG8_SA(0, 1), cA + hstep, voffA);
        if (wr == 1) PG8_BAR;
        PG8_WAIT_V(2); PG8_BAR;
        PG8_STAGE(PG8_SB(1, 0), cB + kstep, voffB); PG8_STAGE(PG8_SA(1, 0), cA + kstep, voffA); PG8_STAGE(PG8_SB(1, 1), cB + hstep + kstep, voffB);
        PG8_WAIT_V(6); PG8_BAR;
    } else {
        PG8_STAGE(PG8_SB(0, 0), cB, voffB); PG8_STAGE(PG8_SA(0, 0), cA, voffA); PG8_STAGE(PG8_SB(0, 1), cB + hstep, voffB); PG8_STAGE(PG8_SA(0, 1), cA + hstep, voffA);
        if (wr == 1) PG8_BAR;
        PG8_WAIT_V(4); PG8_BAR;
        PG8_STAGE(PG8_SB(1, 0), cB + kstep, voffB); PG8_STAGE(PG8_SA(1, 0), cA + kstep, voffA); PG8_STAGE(PG8_SB(1, 1), cB + hstep + kstep, voffB);
        PG8_WAIT_V(6); PG8_BAR;
    }
    for (;;) {
        const bool has_next = S.next(ui + 1, nxt);
        const char* nA = has_next ? (const char*)g.A + (size_t)nxt.pm * tstep : cA; const char* nB = has_next ? (const char*)g.Bt + (size_t)nxt.pn * tstep : cB;
        for (int t = 0; t < nt; t += 2) {
            const bool last = (t == nt - 2);
            const char* a1 = cA + (size_t)(t + 1) * kstep;
            const char* a2 = last ? nA : cA + (size_t)(t + 2) * kstep; const char* b2 = last ? nB : cB + (size_t)(t + 2) * kstep;
            const char* a3 = a2 + kstep; const char* b3 = b2 + kstep;
            if (last && has_next) S.a_ready(nxt);
            if constexpr (SP2) {
            PG8_LDB(B0, 0, 0); PG8_LDB(B1, 0, 1); PG8_SCHED; PG8_LDA(At, 0, 0); PG8_STAGE(PG8_SA(1, 1), a1 + hstep, voffA);
            PG8_WAIT_V(8); PG8_WAIT_L(0); PG8_BAR; PG8_MMA(0, 0, At, B0); PG8_MMA(0, 1, At, B1); PG8_BAR; PG8_SCHED;
            PG8_LDA(At, 0, 1); PG8_STAGE(PG8_SB(0, 0), b2, voffB); PG8_STAGE(PG8_SB(0, 1), b2 + hstep, voffB); PG8_STAGE(PG8_SA(0, 0), a2, voffA);
            PG8_WAIT_V(8); PG8_WAIT_L(0); PG8_BAR; PG8_MMA(1, 0, At, B0); PG8_MMA(1, 1, At, B1); PG8_BAR; PG8_SCHED;
            PG8_LDB(B0, 1, 0); PG8_LDB(B1, 1, 1); PG8_SCHED; PG8_LDA(At, 1, 0); PG8_STAGE(PG8_SA(0, 1), a2 + hstep, voffA);
            PG8_WAIT_V(8); PG8_WAIT_L(0); PG8_BAR; PG8_MMA(0, 0, At, B0); PG8_MMA(0, 1, At, B1); PG8_BAR; PG8_SCHED;
            PG8_LDA(At, 1, 1); PG8_STAGE(PG8_SB(1, 0), b3, voffB); PG8_STAGE(PG8_SB(1, 1), b3 + hstep, voffB); PG8_STAGE(PG8_SA(1, 0), a3, voffA);
            PG8_WAIT_V(8); PG8_WAIT_L(0); PG8_BAR; PG8_MMA(1, 0, At, B0); PG8_MMA(1, 1, At, B1); PG8_BAR; PG8_SCHED;
            } else {
            PG8_LDB(B0, 0, 0); PG8_SCHED; PG8_LDA(At, 0, 0); PG8_STAGE(PG8_SA(1, 1), a1 + hstep, voffA);
            PG8_WAIT_L(8); PG8_BAR; PG8_WAIT_L(0); PG8_MMA(0, 0, At, B0); PG8_BAR; PG8_SCHED;
            PG8_LDB(B1, 0, 1); PG8_STAGE(PG8_SB(0, 0), b2, voffB);
            PG8_BAR; PG8_WAIT_L(0); PG8_MMA(0, 1, At, B1); PG8_BAR;
            PG8_LDA(At, 0, 1); PG8_STAGE(PG8_SA(0, 0), a2, voffA);
            PG8_BAR; PG8_WAIT_L(0); PG8_MMA(1, 0, At, B0); PG8_BAR; PG8_SCHED;
            PG8_STAGE(PG8_SB(0, 1), b2 + hstep, voffB);
            PG8_WAIT_V(6); PG8_BAR; PG8_MMA(1, 1, At, B1); PG8_BAR;
            PG8_LDB(B0, 1, 0); PG8_SCHED; PG8_LDA(At, 1, 0); PG8_STAGE(PG8_SA(0, 1), a2 + hstep, voffA);
            PG8_WAIT_L(8); PG8_BAR; PG8_WAIT_L(0); PG8_MMA(0, 0, At, B0); PG8_BAR; PG8_SCHED;
            PG8_LDB(B1, 1, 1); PG8_STAGE(PG8_SB(1, 0), b3, voffB);
            PG8_BAR; PG8_WAIT_L(0); PG8_MMA(0, 1, At, B1); PG8_BAR;
            PG8_LDA(At, 1, 1); PG8_STAGE(PG8_SA(1, 0), a3, voffA);
            PG8_BAR; PG8_WAIT_L(0); PG8_MMA(1, 0, At, B0); PG8_BAR; PG8_SCHED;
            PG8_STAGE(PG8_SB(1, 1), b3 + hstep, voffB);
            PG8_WAIT_V(6); PG8_BAR; PG8_MMA(1, 1, At, B1); PG8_BAR;
            }
        }
        if constexpr (ALIGN_EPI) { if (wr == 0) PG8_BAR; }
        if constexpr (!Epi::AFTER_DRAIN) { E(acc, cur, wr, wc, fr, fq); S.done(cur); }
        if (!has_next) break;
#pragma unroll
        for (int a = 0; a < 2; ++a)
#pragma unroll
            for (int b = 0; b < 2; ++b)
#pragma unroll
                for (int m = 0; m < 4; ++m)
#pragma unroll
                    for (int n = 0; n < 2; ++n) acc[a][b][m][n] = (f32x4){0.f, 0.f, 0.f, 0.f};
        cur = nxt; cA = nA; cB = nB; ++ui;
        if constexpr (ALIGN_EPI) { if (wr == 1) PG8_BAR; }
    }
    PG8_WAIT_V(0);
    if constexpr (!ALIGN_EPI) { if (wr == 0) PG8_BAR; }
    PG8_BAR;
    if constexpr (Epi::AFTER_DRAIN) { E.fused(acc, cur, wr, wc, fr, fq, lds, wid, lane); S.done(cur); }
#undef PG8_SA
#undef PG8_SB
#undef PG8_STAGE
#undef PG8_LDA
#undef PG8_LDB
#undef PG8_MMA
#undef PG8_WAIT_V
#undef PG8_WAIT_L
#undef PG8_BAR
#undef PG8_SCHED
}
}
#define GAS __attribute__((address_space(1)))
#define LAS __attribute__((address_space(3)))
typedef unsigned short bf16;
typedef unsigned v4u __attribute__((ext_vector_type(4)));
typedef float f32x4 __attribute__((ext_vector_type(4)));
typedef short bf16x8 __attribute__((ext_vector_type(8)));
typedef GAS unsigned gu32;
typedef GAS unsigned long long gu64;
#define RLX_AGENT __ATOMIC_RELAXED, __HIP_MEMORY_SCOPE_AGENT
#define LDS_WAIT() asm volatile("s_waitcnt lgkmcnt(0)" ::: "memory")
#define VM_WAIT() asm volatile("s_waitcnt vmcnt(0)" ::: "memory")
__device__ __forceinline__ unsigned long long rt() { return __builtin_amdgcn_s_memrealtime(); }
__device__ __forceinline__ unsigned f2bf(float f) { unsigned u = __builtin_bit_cast(unsigned, f); return (u + 0x7fffu + ((u >> 16) & 1u)) >> 16; }
__device__ __forceinline__ unsigned pk2(float lo, float hi) { return f2bf(lo) | (f2bf(hi) << 16); }

#define XB_TMO      128
#define XB_XCNT(j)  (256  + 64 * (j))
#define XB_XSUB(j)  (1280 + 64 * (j))
#define XB_XGEN(j)  (2304 + 64 * (j))
#define XB_TOP      3328
#define XB_TOPGEN   3392
#define XCD_BAR_WORDS 3456
#define XB_SPIN_CAP (1u << 18)

__device__ __forceinline__ unsigned xb_ld(unsigned* p)              { return __hip_atomic_load(p, __ATOMIC_RELAXED, __HIP_MEMORY_SCOPE_AGENT); }
__device__ __forceinline__ unsigned xb_add(unsigned* p, unsigned v) { return __hip_atomic_fetch_add(p, v, __ATOMIC_RELAXED, __HIP_MEMORY_SCOPE_AGENT); }
__device__ __forceinline__ unsigned xb_xcc_id() { return (unsigned)__builtin_amdgcn_s_getreg((3 << 11) | 20) & 0xFu; }
#define XB_SPIN(cond, bar) do { unsigned _sp = 0; while (cond) { __builtin_amdgcn_s_sleep(1); \
    if ((++_sp & 255u) == 0u) { if (xb_ld(&(bar)[XB_TMO])) break; if (_sp > XB_SPIN_CAP) { atomicAdd(&(bar)[XB_TMO], 1u); break; } } } } while (0)

struct XcdBarrier {
    unsigned* bar; unsigned x;
    volatile LAS unsigned* st;
};

__device__ __forceinline__ XcdBarrier xcd_barrier_post(unsigned* bar, volatile LAS unsigned* st) {
    XcdBarrier b; b.bar = bar; b.x = xb_xcc_id(); b.st = st;
    if (threadIdx.x == 0) (void)xb_add(&bar[XB_XCNT(b.x)], 1u);
    return b;
}
__device__ __forceinline__ void xcd_barrier_complete(unsigned* bar, unsigned x, unsigned& nloc, unsigned& nx) {
    const unsigned G = gridDim.x * gridDim.y * gridDim.z;
    unsigned sum, cnt, mine, sp = 0u;
    for (;;) {
        sum = 0u; cnt = 0u; mine = 0u;
#pragma unroll
        for (unsigned j = 0; j < 16; ++j) { const unsigned c = xb_ld(&bar[XB_XCNT(j)]); sum += c; cnt += (c > 0u) ? 1u : 0u; mine = (j == x) ? c : mine; }
        if (sum == G) break;
        __builtin_amdgcn_s_sleep(1);
        if ((++sp & 255u) == 0u) { if (xb_ld(&bar[XB_TMO])) break; if (sp > XB_SPIN_CAP) { atomicAdd(&bar[XB_TMO], 1u); break; } }
    }
    nloc = mine > 0u ? mine : 1u; nx = cnt > 0u ? cnt : 1u;
}

__device__ __forceinline__ void xcd_barrier(const XcdBarrier& b) {
    asm volatile("s_waitcnt vmcnt(0)" ::: "memory");
    __syncthreads();
    if (threadIdx.x == 0) {
        unsigned* bar = b.bar;
        __builtin_amdgcn_s_waitcnt(0);
        unsigned nloc = b.st[0], nx = b.st[1];
        if (nloc == 0u) { xcd_barrier_complete(bar, b.x, nloc, nx); b.st[0] = nloc; b.st[1] = nx; }
        const unsigned old = xb_add(&bar[XB_XSUB(b.x)], 1u);
        const unsigned gen = old / nloc;
        if (old + 1u == (gen + 1u) * nloc) {
            __builtin_amdgcn_fence(__ATOMIC_RELEASE, "agent");
            asm volatile("s_waitcnt vmcnt(0)" ::: "memory");
            const unsigned og = xb_add(&bar[XB_TOP], 1u);
            const unsigned tg = og / nx;
            if (og + 1u == (tg + 1u) * nx) xb_add(&bar[XB_TOPGEN], 1u);
            else XB_SPIN(xb_ld(&bar[XB_TOPGEN]) == tg, bar);
            __builtin_amdgcn_fence(__ATOMIC_ACQUIRE, "agent");
            xb_add(&bar[XB_XGEN(b.x)], 1u);
            asm volatile("s_waitcnt vmcnt(0)" ::: "memory");
        } else {
            XB_SPIN(xb_ld(&bar[XB_XGEN(b.x)]) == gen, bar);
            __builtin_amdgcn_fence(__ATOMIC_ACQUIRE, "agent");
            asm volatile("s_waitcnt vmcnt(0)" ::: "memory");
        }
    }
    __syncthreads();
}
constexpr int NWAVES = 8;
constexpr int DM = 1024, BATCH = 4, SEQ = 4096, NB = 128  , MPROMPT = BATCH * SEQ, MREAL = MPROMPT + NB, MP = 16640  ;
constexpr int NPROJ = 2304, LDW_IN = 2312, DFF = 2816, NGU = 2 * DFF;
constexpr int C_Q = 0, C_K = 512, C_V = 640, C_Z = 768, C_XBC = 1280, C_B = 1792, C_C = 2048;
constexpr float EPS = 1e-6f;
constexpr size_t O_YP = 0, O_YS = 16777216, O_KP = 16908288, O_VP = 16973824, O_CP = 17039360, O_SP = 17051648, O_KS = 17313792, O_VS = 19410944, O_CS = 21508096, O_SS = 21901312, O_END = 30289920;
constexpr size_t MiB = 1u << 20;
constexpr size_t WS_CTL = 0, CTL_ZERO_BYTES = 1 * MiB;
constexpr size_t WS_WIN = 2 * MiB;
constexpr size_t WS_WOUT = 7 * MiB;
constexpr size_t WS_WGU = 9 * MiB;
constexpr size_t WS_WD = 20 * MiB;
constexpr size_t WS_DT = 26 * MiB;
constexpr size_t WS_SSQ1 = 27 * MiB;
constexpr size_t WS_XN = 32 * MiB;
constexpr size_t WS_PROJ = 66 * MiB;
constexpr size_t WS_MIX = 140 * MiB;
constexpr size_t WS_YS = 174 * MiB;
constexpr size_t WS_XC = 208 * MiB;
constexpr size_t WS_END = 256 * MiB;
static_assert(WS_PROJ + (size_t)MP * DFF * 2 <= WS_YS && WS_XC + (size_t)MP * 1024 * 2 <= WS_END, "ws map");
constexpr int CW_BAR = 4096;

constexpr int RING_OFF = 0, RING_BYTES = 131072;
constexpr int LDS_BYTES = 163840;
constexpr int MISC_OFF = LDS_BYTES - 256;

__device__ const unsigned char BUCKET[128] = {0, 1, 2, 3, 4, 5, 6, 7, 8, 9, 10, 11, 12, 13, 14, 15, 16, 16, 16, 17, 17, 18, 18, 18, 19, 19, 19, 20, 20, 20, 20, 21, 21, 21, 21, 22, 22, 22, 22, 22, 23, 23, 23, 23, 23, 23, 24, 24, 24, 24, 24, 24, 25, 25, 25, 25, 25, 25, 25, 26, 26, 26, 26, 26, 26, 26, 26, 27, 27, 27, 27, 27, 27, 27, 27, 27, 27, 28, 28, 28, 28, 28, 28, 28, 28, 28, 28, 29, 29, 29, 29, 29, 29, 29, 29, 29, 29, 29, 29, 30, 30, 30, 30, 30, 30, 30, 30, 30, 30, 30, 30, 30, 30, 31, 31, 31, 31, 31, 31, 31, 31, 31, 31, 31, 31, 31, 31, 31};

__device__ __forceinline__ float bf2f(unsigned short b) { return __uint_as_float((unsigned)b << 16); }
__device__ __forceinline__ float wave_sum(float v) {
#pragma unroll
    for (int o = 1; o < 64; o <<= 1) v += __shfl_xor(v, o);
    return v;
}
__device__ __forceinline__ float wave_max(float v) {
#pragma unroll
    for (int o = 1; o < 64; o <<= 1) v = fmaxf(v, __shfl_xor(v, o));
    return v;
}
__device__ __forceinline__ float silu_f(float a) { return a / (1.0f + __expf(-a)); }
__device__ __forceinline__ float softplus_f(float v) { return fmaxf(v, 0.f) + log1pf(expf(-fabsf(v))); }

struct Frame {
    LAS unsigned char* lds;
    int tid, lane, wave, G, vcu;
    const float* in[22]; float* out; unsigned char* ws;
};

template <class RowMap>
__device__ __forceinline__ void p0_transpose_item(const float* W, int ldw, int nblk, const float* kscale, bf16* WT, int ldo, RowMap rm, LAS float* scr, int item, int lane) {
    const int kb = item / nblk, nb = item % nblk, k0 = 64 * kb, n0 = 32 * nb;
#pragma unroll 8
    for (int i = 0; i < 32; ++i) { const int kk = 2 * i + (lane >> 5); float v = W[(size_t)(k0 + kk) * ldw + n0 + (lane & 31)]; if (kscale) v *= kscale[k0 + kk]; scr[kk * 33 + (lane & 31)] = v; }
    LDS_WAIT(); asm volatile("" ::: "memory");
    const int c = lane & 7;
#pragma unroll
    for (int j = 0; j < 4; ++j) { const int n = (lane >> 3) + 8 * j; const LAS float* s = scr + (8 * c) * 33 + n;
        v4u o; o.x = pk2(s[0 * 33], s[1 * 33]); o.y = pk2(s[2 * 33], s[3 * 33]); o.z = pk2(s[4 * 33], s[5 * 33]); o.w = pk2(s[6 * 33], s[7 * 33]);
        *(GAS v4u*)(WT + (size_t)rm(n0 + n) * ldo + k0 + 8 * c) = o; }
    LDS_WAIT(); asm volatile("" ::: "memory");
}
struct RmId { __device__ __forceinline__ int operator()(int n) const { return n; } };
struct RmGU { int up; __device__ __forceinline__ int operator()(int n) const { return 8 * (n >> 2) + (n & 3) + 4 * up; } };

__device__ __forceinline__ void p0_prologue(Frame& F) {
    const float* x_p = F.in[0]; const float* x_s = F.in[1]; const float* norm1 = F.in[7]; const float* w_in = F.in[8]; const float* dt_bias = F.in[12];
    bf16* XN = (bf16*)(F.ws + WS_XN); float* DT = (float*)(F.ws + WS_DT);
    LAS float* wdt = (LAS float*)(F.lds);
    LAS float* scr = (LAS float*)(F.lds + 32768 + F.wave * 12288);
    for (int i = F.tid; i < 8192; i += NWAVES * 64) { const int k = i >> 3, j = i & 7; wdt[j * 1024 + k] = w_in[(size_t)k * LDW_IN + NPROJ + j]; }
    __syncthreads();
    const int gw = F.vcu * NWAVES + F.wave, NGW = F.G * NWAVES;
    constexpr int I_IN = 16 * 72, I_OUT = 16 * 32, I_G = 16 * 88, I_D = 44 * 32, NITEMS = I_IN + I_OUT + 2 * I_G + I_D;
    for (int it = gw; it < NITEMS; it += NGW) {
        int r = it;
        if (r < I_IN) { p0_transpose_item(F.in[8], LDW_IN, 72, (const float*)nullptr, (bf16*)(F.ws + WS_WIN), 1024, RmId{}, scr, r, F.lane); continue; } r -= I_IN;
        if (r < I_OUT) { p0_transpose_item(F.in[16], 1024, 32, (const float*)nullptr, (bf16*)(F.ws + WS_WOUT), 1024, RmId{}, scr, r, F.lane); continue; } r -= I_OUT;
        if (r < I_G) { p0_transpose_item(F.in[18], DFF, 88, F.in[17], (bf16*)(F.ws + WS_WGU), 1024, RmGU{0}, scr, r, F.lane); continue; } r -= I_G;
        if (r < I_G) { p0_transpose_item(F.in[19], DFF, 88, F.in[17], (bf16*)(F.ws + WS_WGU), 1024, RmGU{1}, scr, r, F.lane); continue; } r -= I_G;
        p0_transpose_item(F.in[20], 1024, 32, (const float*)nullptr, (bf16*)(F.ws + WS_WD), DFF, RmId{}, scr, r, F.lane);
    }
    f32x4 w1[4];
#pragma unroll
    for (int j = 0; j < 4; ++j) w1[j] = ((const f32x4*)norm1)[64 * j + F.lane];
    for (int m = gw; m < MP; m += NGW) {
        GAS unsigned long long* o8 = (GAS unsigned long long*)(XN + (size_t)m * DM) + F.lane;
        if (m >= MREAL) {
#pragma unroll
            for (int j = 0; j < 4; ++j) o8[64 * j] = 0ull;
            continue; }
        const float* xrow = m < MPROMPT ? x_p + (size_t)m * DM : x_s + (size_t)(m - MPROMPT) * DM;
        const f32x4* xr = (const f32x4*)xrow + F.lane;
        f32x4 v[4]; float s = 0.f;
#pragma unroll
        for (int j = 0; j < 4; ++j) { v[j] = xr[64 * j]; s += (v[j][0] * v[j][0] + v[j][1] * v[j][1]) + (v[j][2] * v[j][2] + v[j][3] * v[j][3]); }
        const float rstd = 1.0f / sqrtf(wave_sum(s) * (1.0f / DM) + EPS);
        float d[8];
#pragma unroll
        for (int q = 0; q < 8; ++q) d[q] = 0.f;
#pragma unroll
        for (int j = 0; j < 4; ++j) { v[j] = v[j] * w1[j] * rstd;
#pragma unroll
            for (int q = 0; q < 8; ++q) { const f32x4 wq = *(const LAS f32x4*)(wdt + q * 1024 + 256 * j + 4 * F.lane); d[q] += (v[j][0] * wq[0] + v[j][1] * wq[1]) + (v[j][2] * wq[2] + v[j][3] * wq[3]); } }
#pragma unroll
        for (int q = 0; q < 8; ++q) d[q] = wave_sum(d[q]);
        float dsel = d[0];
#pragma unroll
        for (int q = 1; q < 8; ++q) dsel = (F.lane == q) ? d[q] : dsel;
        if (F.lane < 8) DT[(size_t)m * 8 + F.lane] = softplus_f(dsel + dt_bias[F.lane]);
#pragma unroll
        for (int j = 0; j < 4; ++j) o8[64 * j] = (unsigned long long)pk2(v[j][0], v[j][1]) | ((unsigned long long)pk2(v[j][2], v[j][3]) << 32);
    }
    const int gt = F.vcu * NWAVES * 64 + F.tid, NGT = F.G * NWAVES * 64;
    for (int i = gt; i < NB * 4064; i += NGT) { const int b = i / 4064, r = i % 4064;
        ((f32x4*)(F.out + O_KS + (size_t)b * 16384))[r] = ((const f32x4*)(F.in[2] + (size_t)b * 16384 + 128))[r];
        ((f32x4*)(F.out + O_VS + (size_t)b * 16384))[r] = ((const f32x4*)(F.in[3] + (size_t)b * 16384 + 128))[r]; }
    for (int i = gt; i < NB * 512; i += NGT) { const int b = i / 512, r = i % 512;
        ((f32x4*)(F.out + O_CS + (size_t)b * 3072))[r] = ((const f32x4*)(F.in[4] + (size_t)b * 3072 + 1024))[r]; }
}

__device__ __forceinline__ void p3_attn_naive(Frame& F, int m_lo) {
    const bf16* PROJ = (const bf16*)(F.ws + WS_PROJ); bf16* MIX = (bf16*)(F.ws + WS_MIX);
    const float* ck = F.in[2]; const float* cv = F.in[3]; const float* relb = F.in[6]; const float* sinks = F.in[9];
    const int gw = F.vcu * NWAVES + F.wave, NGW = F.G * NWAVES, lane = F.lane;
    for (int task = m_lo * 8 + gw; task < MREAL * 8; task += NGW) { const int m = task >> 3, hh = task & 7, kvh = hh >> 2;
        const bool prompt = m < MPROMPT; const int t = m & (SEQ - 1), b = prompt ? (m >> 12) : (m - MPROMPT);
        float q[64];
        { const bf16* qp = PROJ + (size_t)m * NPROJ + C_Q + hh * 64;
#pragma unroll
          for (int d8 = 0; d8 < 8; ++d8) { const v4u w = *(const v4u*)(qp + d8 * 8);
#pragma unroll
              for (int e = 0; e < 4; ++e) { q[d8 * 8 + 2 * e] = __uint_as_float(w[e] << 16); q[d8 * 8 + 2 * e + 1] = __uint_as_float(w[e] & 0xffff0000u); } } }
        float s[2];
#pragma unroll
        for (int half = 0; half < 2; ++half) { const int i = lane + 64 * half; float acc = 0.f; bool valid = true;
            if (prompt) { const int kt = t - 127 + i; valid = kt >= 0;
                if (valid) { const bf16* kp = PROJ + (size_t)(m - 127 + i) * NPROJ + C_K + kvh * 64;
#pragma unroll
                    for (int d8 = 0; d8 < 8; ++d8) { const v4u w = *(const v4u*)(kp + d8 * 8);
#pragma unroll
                        for (int e = 0; e < 4; ++e) acc += q[d8 * 8 + 2 * e] * __uint_as_float(w[e] << 16) + q[d8 * 8 + 2 * e + 1] * __uint_as_float(w[e] & 0xffff0000u); } } }
            else if (i < 127) { const float* kp = ck + ((size_t)b * 128 + i + 1) * 128 + kvh * 64;
#pragma unroll
                for (int d4 = 0; d4 < 16; ++d4) { const f32x4 w = *(const f32x4*)(kp + d4 * 4); acc += (q[d4 * 4] * w[0] + q[d4 * 4 + 1] * w[1]) + (q[d4 * 4 + 2] * w[2] + q[d4 * 4 + 3] * w[3]); } }
            else { const bf16* kp = PROJ + (size_t)m * NPROJ + C_K + kvh * 64;
#pragma unroll
                for (int d8 = 0; d8 < 8; ++d8) { const v4u w = *(const v4u*)(kp + d8 * 8);
#pragma unroll
                    for (int e = 0; e < 4; ++e) acc += q[d8 * 8 + 2 * e] * __uint_as_float(w[e] << 16) + q[d8 * 8 + 2 * e + 1] * __uint_as_float(w[e] & 0xffff0000u); } }
            s[half] = valid ? acc * 0.125f + relb[BUCKET[127 - i] * 8 + hh] : -INFINITY; }
        const float sk = sinks[hh];
        const float mx = fmaxf(wave_max(fmaxf(s[0], s[1])), sk);
        float p0 = __expf(s[0] - mx), p1 = __expf(s[1] - mx);
        const float den = wave_sum(p0 + p1) + __expf(sk - mx), inv = 1.0f / den;
        p0 *= inv; p1 *= inv;
        float o = 0.f;
        for (int i = 0; i < 128; ++i) { const float p = __shfl(i < 64 ? p0 : p1, i & 63);
            float v = 0.f;
            if (prompt) { if (t - 127 + i >= 0) v = bf2f(PROJ[(size_t)(m - 127 + i) * NPROJ + C_V + kvh * 64 + lane]); }
            else if (i < 127) v = cv[((size_t)b * 128 + i + 1) * 128 + kvh * 64 + lane];
            else v = bf2f(PROJ[(size_t)m * NPROJ + C_V + kvh * 64 + lane]);
            o += p * v; }
        MIX[(size_t)m * 1024 + hh * 64 + lane] = (bf16)f2bf(o);
    }
}
typedef float f32x16 __attribute__((ext_vector_type(16)));
typedef unsigned long long u64;
__device__ __forceinline__ int crow(int r, int h) { return (r & 3) + 8 * (r >> 2) + 4 * h; }
__device__ __forceinline__ bf16x8 pack8(float a0, float a1, float a2, float a3, float a4, float a5, float a6, float a7) {
    v4u w; w.x = pk2(a0, a1); w.y = pk2(a2, a3); w.z = pk2(a4, a5); w.w = pk2(a6, a7); return __builtin_bit_cast(bf16x8, w);
}
constexpr int AT_KP = 144, AT_VP = 520;
constexpr int AT_K = 0, AT_V = 256 * AT_KP, AT_BIAS = AT_V + 64 * AT_VP, AT_LW = AT_BIAS + 3072, AT_END = AT_LW + 1024;
__device__ __forceinline__ void attn_unit(Frame& F, int b, int nblk, int kvh) {
    const bf16* PROJ = (const bf16*)(F.ws + WS_PROJ); bf16* MIX = (bf16*)(F.ws + WS_MIX);
    const float* relb = F.in[6]; const float* sinks = F.in[9];
    LAS unsigned char* L = F.lds;
    LAS float* BIASL = (LAS float*)(L + AT_BIAS); LAS float* LW = (LAS float*)(L + AT_LW);
    const int tid = F.tid, lane = F.lane, wave = F.wave, r32 = lane & 31, h = lane >> 5;
    constexpr float LOG2E = 1.4426950408889634f;
    { const int row = tid & 255; const int trow = (nblk - 1) * 128 + row; const bool ok = trow >= 0;
      const bf16* src = PROJ + (size_t)(b * SEQ + (ok ? trow : 0)) * NPROJ + kvh * 64;
#pragma unroll
      for (int k = 0; k < 4; ++k) { const int c16 = 2 * k + (tid >> 8);
          v4u kq = ok ? *(const v4u*)(src + C_K + c16 * 8) : (v4u){0u, 0u, 0u, 0u};
          v4u vq = ok ? *(const v4u*)(src + C_V + c16 * 8) : (v4u){0u, 0u, 0u, 0u};
          *(LAS v4u*)(L + AT_K + row * AT_KP + c16 * 16) = kq;
#pragma unroll
          for (int e = 0; e < 8; ++e) *(LAS unsigned short*)(L + AT_V + (c16 * 8 + e) * AT_VP + row * 2) = (unsigned short)(vq[e >> 1] >> (16 * (e & 1))); }
      for (int i = tid; i < 768; i += NWAVES * 64) { const int rr = i / 192, d = i % 192 - 32;
          BIASL[i] = (d >= 0 && d < 128) ? relb[BUCKET[d & 127] * 8 + kvh * 4 + rr] * LOG2E : 0.f; } }
    __syncthreads();
    const int r = wave >> 1, half = wave & 1, hh = kvh * 4 + r;
    const float sink2 = sinks[hh] * LOG2E;
#pragma unroll 1
    for (int qq = 0; qq < 2; ++qq) {
        const int q0 = half * 64 + qq * 32;
        const size_t mq = (size_t)b * SEQ + nblk * 128 + q0;
        bf16x8 qf[4];
#pragma unroll
        for (int ks = 0; ks < 4; ++ks) qf[ks] = *(const bf16x8*)(PROJ + (mq + r32) * NPROJ + C_Q + hh * 64 + ks * 16 + h * 8);
        f32x16 st[5];
#pragma unroll
        for (int kk = 0; kk < 5; ++kk) { st[kk] = (f32x16){0.f, 0.f, 0.f, 0.f, 0.f, 0.f, 0.f, 0.f, 0.f, 0.f, 0.f, 0.f, 0.f, 0.f, 0.f, 0.f};
            const LAS unsigned char* kp = L + AT_K + (q0 + kk * 32 + r32) * AT_KP + h * 16;
#pragma unroll
            for (int ks = 0; ks < 4; ++ks) { const bf16x8 kf = *(const LAS bf16x8*)(kp + ks * 32); st[kk] = __builtin_amdgcn_mfma_f32_32x32x16_bf16(kf, qf[ks], st[kk], 0, 0, 0); }
            __builtin_amdgcn_sched_barrier(0); }
        float mx = -INFINITY; const LAS float* bl = BIASL + r * 192 + 32 + r32 + 128 - 4 * h;
#pragma unroll
        for (int kk = 0; kk < 5; ++kk)
#pragma unroll
            for (int reg = 0; reg < 16; ++reg) { const int krel = kk * 32 + crow(reg, h);
                const int dist = r32 + 128 - krel; const int kj = q0 + krel;
                const bool valid = dist >= 0 && dist < 128 && (nblk > 0 || kj >= 128);
                const float s = valid ? st[kk][reg] * (0.125f * LOG2E) + bl[-(kk * 32 + (reg & 3) + 8 * (reg >> 2))] : -INFINITY;
                st[kk][reg] = s; mx = fmaxf(mx, s); }
        mx = fmaxf(mx, __shfl_xor(mx, 32)); mx = fmaxf(mx, sink2);
        float l = 0.f;
#pragma unroll
        for (int kk = 0; kk < 5; ++kk)
#pragma unroll
            for (int reg = 0; reg < 16; ++reg) { const float p = __builtin_amdgcn_exp2f(st[kk][reg] - mx); st[kk][reg] = p; l += p; }
        l += __shfl_xor(l, 32); l += __builtin_amdgcn_exp2f(sink2 - mx);
        if (h == 0) LW[wave * 32 + r32] = 1.0f / l;
        f32x16 o[2];
        o[0] = (f32x16){0.f, 0.f, 0.f, 0.f, 0.f, 0.f, 0.f, 0.f, 0.f, 0.f, 0.f, 0.f, 0.f, 0.f, 0.f, 0.f}; o[1] = o[0];
#pragma unroll
        for (int kk = 0; kk < 5; ++kk)
#pragma unroll
            for (int s = 0; s < 2; ++s) { const bf16x8 pf = pack8(st[kk][8 * s], st[kk][8 * s + 1], st[kk][8 * s + 2], st[kk][8 * s + 3], st[kk][8 * s + 4], st[kk][8 * s + 5], st[kk][8 * s + 6], st[kk][8 * s + 7]);
#pragma unroll
                for (int db = 0; db < 2; ++db) { const LAS unsigned char* vp = L + AT_V + (db * 32 + r32) * AT_VP + (q0 + kk * 32 + 16 * s + 4 * h) * 2;
                    const u64 lo = *(const LAS u64*)vp, hi = *(const LAS u64*)(vp + 16);
                    typedef u64 u64x2 __attribute__((ext_vector_type(2))); const u64x2 vv = {lo, hi};
                    o[db] = __builtin_amdgcn_mfma_f32_32x32x16_bf16(pf, __builtin_bit_cast(bf16x8, vv), o[db], 0, 0, 0); }
                __builtin_amdgcn_sched_barrier(0); }
        LDS_WAIT();
#pragma unroll
        for (int reg = 0; reg < 16; ++reg) { const int qi = crow(reg, h); const float inv = LW[wave * 32 + qi];
#pragma unroll
            for (int db = 0; db < 2; ++db) MIX[(mq + qi) * 1024 + hh * 64 + db * 32 + r32] = (bf16)f2bf(o[db][reg] * inv); }
    }
    __syncthreads();
}
constexpr size_t WS_STATES = 174 * MiB;
constexpr size_t WS_HPREV = 190 * MiB;
constexpr size_t WS_DEC = 28 * MiB + 512 * 1024;
static_assert(WS_HPREV + 16 * MiB <= WS_XC, "ws map (ssd)");
constexpr int SP = 272;
__device__ __forceinline__ float silu_fast(float a) { return a * __builtin_amdgcn_rcpf(1.0f + __expf(-a)); }

__device__ __forceinline__ void conv_task(const bf16* PROJ, long m0, int t0, int j0, int chx, const float* cw, const float* cb, float (&o)[4][8]) {
    float x[11][4];
#pragma unroll
    for (int k = 0; k < 11; ++k) { const int tok = t0 + j0 - 3 + k;
        if (tok >= 0) { const u64 q = *(const u64*)(PROJ + (size_t)(m0 + j0 - 3 + k) * NPROJ + C_XBC + chx);
#pragma unroll
            for (int e = 0; e < 4; ++e) x[k][e] = bf2f((unsigned short)(q >> (16 * e))); }
        else {
#pragma unroll
            for (int e = 0; e < 4; ++e) x[k][e] = 0.f; } }
    const f32x4 w0 = *(const f32x4*)(cw + chx), w1 = *(const f32x4*)(cw + 1024 + chx), w2 = *(const f32x4*)(cw + 2048 + chx), w3 = *(const f32x4*)(cw + 3072 + chx), bb = *(const f32x4*)(cb + chx);
#pragma unroll
    for (int jj = 0; jj < 8; ++jj)
#pragma unroll
        for (int e = 0; e < 4; ++e) o[e][jj] = silu_fast(bb[e] + w0[e] * x[jj][e] + w1[e] * x[jj + 1][e] + w2[e] * x[jj + 2][e] + w3[e] * x[jj + 3][e]);
}
__device__ __forceinline__ void chunk_cumsum(const float* DT, long m0, int hd, float A, int lane, float& cs0, float& cs1, float& dt0, float& dt1, float& cend) {
    dt0 = DT[(size_t)(m0 + 2 * lane) * 8 + hd]; dt1 = DT[(size_t)(m0 + 2 * lane + 1) * 8 + hd];
    const float a0 = dt0 * A, a1 = dt1 * A; float incl = a0 + a1;
#pragma unroll
    for (int o = 1; o < 64; o <<= 1) { const float t = __shfl_up(incl, o); if (lane >= o) incl += t; }
    const float ex = incl - (a0 + a1); cs0 = ex + a0; cs1 = ex + (a0 + a1); cend = __shfl(incl, 63);
}

__device__ __forceinline__ void ssd_part1_unit(Frame& F, int b, int c, int g) {
    const bf16* PROJ = (const bf16*)(F.ws + WS_PROJ); const float* DT = (const float*)(F.ws + WS_DT);
    bf16* STATES = (bf16*)(F.ws + WS_STATES); float* DEC = (float*)(F.ws + WS_DEC);
    const float* cw = F.in[10]; const float* cb = F.in[11]; const float* A_log = F.in[13];
    LAS unsigned char* L = F.lds; LAS unsigned char* XwT = L; LAS unsigned char* BT = L + 256 * SP; LAS float* WL = (LAS float*)(L + 384 * SP);
    const int lane = F.lane, wave = F.wave, r32 = lane & 31, h = lane >> 5;
    const long m0 = (long)b * SEQ + c * 128; const int t0 = c * 128;
    if (wave < 4) { const int hd = 4 * g + wave; float cs0, cs1, dt0, dt1, cend;
        chunk_cumsum(DT, m0, hd, -expf(A_log[hd]), lane, cs0, cs1, dt0, dt1, cend);
        WL[wave * 128 + 2 * lane] = dt0 * __expf(cend - cs0); WL[wave * 128 + 2 * lane + 1] = dt1 * __expf(cend - cs1);
        if (lane == 0) DEC[(b * 32 + c) * 8 + hd] = __expf(cend); }
    __syncthreads();
#pragma unroll 1
    for (int k = 0; k < 2; ++k) { const int tr = wave + 8 * k, cq = lane, j0 = tr * 8; float o[4][8];
        conv_task(PROJ, m0, t0, j0, g * 256 + 4 * cq, cw, cb, o);
        const LAS float* wl = WL + (cq >> 4) * 128 + j0; float w[8];
#pragma unroll
        for (int jj = 0; jj < 8; ++jj) w[jj] = wl[jj];
#pragma unroll
        for (int e = 0; e < 4; ++e) *(LAS bf16x8*)(XwT + (4 * cq + e) * SP + j0 * 2) = pack8(o[e][0] * w[0], o[e][1] * w[1], o[e][2] * w[2], o[e][3] * w[3], o[e][4] * w[4], o[e][5] * w[5], o[e][6] * w[6], o[e][7] * w[7]); }
    { const int tr = wave * 2 + h, cq = r32, j0 = tr * 8; float o[4][8];
        conv_task(PROJ, m0, t0, j0, 512 + g * 128 + 4 * cq, cw, cb, o);
#pragma unroll
        for (int e = 0; e < 4; ++e) *(LAS bf16x8*)(BT + (4 * cq + e) * SP + j0 * 2) = pack8(o[e][0], o[e][1], o[e][2], o[e][3], o[e][4], o[e][5], o[e][6], o[e][7]); }
    __syncthreads();
    const int r = wave >> 1, pb = wave & 1, hd = 4 * g + r;
    f32x16 acc[4];
#pragma unroll
    for (int nb = 0; nb < 4; ++nb) acc[nb] = (f32x16){0.f, 0.f, 0.f, 0.f, 0.f, 0.f, 0.f, 0.f, 0.f, 0.f, 0.f, 0.f, 0.f, 0.f, 0.f, 0.f};
    const LAS unsigned char* ap = XwT + (r * 64 + pb * 32 + r32) * SP + h * 16; const LAS unsigned char* bp = BT + r32 * SP + h * 16;
#pragma unroll
    for (int ks = 0; ks < 8; ++ks) { const bf16x8 a = *(const LAS bf16x8*)(ap + ks * 32);
#pragma unroll
        for (int nb = 0; nb < 4; ++nb) { const bf16x8 bb = *(const LAS bf16x8*)(bp + nb * 32 * SP + ks * 32); acc[nb] = __builtin_amdgcn_mfma_f32_32x32x16_bf16(a, bb, acc[nb], 0, 0, 0); } }
    bf16* sp = STATES + ((size_t)((b * 32 + c) * 8 + hd) * 64 + pb * 32) * 128 + r32;
#pragma unroll
    for (int reg = 0; reg < 16; ++reg)
#pragma unroll
        for (int nb = 0; nb < 4; ++nb) sp[(size_t)crow(reg, h) * 128 + nb * 32] = (bf16)f2bf(acc[nb][reg]);
    __syncthreads();
}

__device__ __forceinline__ void ssd_scan(Frame& F) {
    const bf16* STATES = (const bf16*)(F.ws + WS_STATES); bf16* HPREV = (bf16*)(F.ws + WS_HPREV); const float* DEC = (const float*)(F.ws + WS_DEC);
    const int gt = F.vcu * NWAVES * 64 + F.tid, NGT = F.G * NWAVES * 64;
    for (int e = gt; e < BATCH * 8 * 64 * 64; e += NGT) { const int n2 = e & 63, p = (e >> 6) & 63, hd = (e >> 12) & 7, b = e >> 15;
        float h0 = 0.f, h1 = 0.f; unsigned st[32];
#pragma unroll
        for (int c = 0; c < 32; ++c) st[c] = *(const unsigned*)(STATES + ((size_t)((b * 32 + c) * 8 + hd) * 64 + p) * 128 + 2 * n2);
#pragma unroll
        for (int c = 0; c < 32; ++c) { *(unsigned*)(HPREV + ((size_t)((b * 32 + c) * 8 + hd) * 64 + p) * 128 + 2 * n2) = pk2(h0, h1);
            const float d = DEC[(b * 32 + c) * 8 + hd]; h0 = h0 * d + __uint_as_float(st[c] << 16); h1 = h1 * d + __uint_as_float(st[c] & 0xffff0000u); }
        *(float2*)(F.out + O_SP + ((size_t)((b * 8 + hd) * 64 + p)) * 128 + 2 * n2) = make_float2(h0, h1); }
}

__device__ __forceinline__ void ssd_part2_unit(Frame& F, int b, int c, int g) {
    const bf16* PROJ = (const bf16*)(F.ws + WS_PROJ); const float* DT = (const float*)(F.ws + WS_DT); const bf16* HPREV = (const bf16*)(F.ws + WS_HPREV); bf16* MIX = (bf16*)(F.ws + WS_MIX);
    const float* cw = F.in[10]; const float* cb = F.in[11]; const float* A_log = F.in[13]; const float* Dsk = F.in[14]; const float* nw = F.in[15];
    LAS unsigned char* L = F.lds; LAS unsigned char* Btok = L; LAS unsigned char* Ctok = L + 128 * SP; LAS unsigned char* XT = L + 256 * SP;
    LAS float* CS = (LAS float*)(L + 512 * SP); LAS float* DTL = CS + 512; LAS float* RSQ = DTL + 512;
    const int lane = F.lane, wave = F.wave, r32 = lane & 31, h = lane >> 5;
    const long m0 = (long)b * SEQ + c * 128; const int t0 = c * 128;
    if (wave < 4) { const int hd = 4 * g + wave; float cs0, cs1, dt0, dt1, cend;
        chunk_cumsum(DT, m0, hd, -expf(A_log[hd]), lane, cs0, cs1, dt0, dt1, cend);
        CS[wave * 128 + 2 * lane] = cs0; CS[wave * 128 + 2 * lane + 1] = cs1; DTL[wave * 128 + 2 * lane] = dt0; DTL[wave * 128 + 2 * lane + 1] = dt1; }
#pragma unroll 1
    for (int k = 0; k < 2; ++k) { const int tr = wave + 8 * k, cq = lane, j0 = tr * 8; float o[4][8];
        conv_task(PROJ, m0, t0, j0, g * 256 + 4 * cq, cw, cb, o);
#pragma unroll
        for (int e = 0; e < 4; ++e) *(LAS bf16x8*)(XT + (4 * cq + e) * SP + j0 * 2) = pack8(o[e][0], o[e][1], o[e][2], o[e][3], o[e][4], o[e][5], o[e][6], o[e][7]); }
#pragma unroll 1
    for (int k = 0; k < 2; ++k) { const int tr = wave * 2 + h, cq = r32, j0 = tr * 8; float o[4][8];
        conv_task(PROJ, m0, t0, j0, 512 + k * 256 + g * 128 + 4 * cq, cw, cb, o);
        LAS unsigned char* dst = (k == 0 ? Btok : Ctok) + j0 * SP + cq * 8;
#pragma unroll
        for (int jj = 0; jj < 8; ++jj) *(LAS u64*)(dst + jj * SP) = (u64)pk2(o[0][jj], o[1][jj]) | ((u64)pk2(o[2][jj], o[3][jj]) << 32); }
    __syncthreads();
    const int r = wave >> 1, sel = wave & 1, hd = 4 * g + r; const float Dv = Dsk[hd];
    const LAS float* csr = CS + r * 128; const LAS float* dtr = DTL + r * 128;
    float vkeep[2][2][16];
#pragma unroll
    for (int ibk = 0; ibk < 2; ++ibk) {
        const int ib = sel ? (1 + ibk) : (3 * ibk);
        bf16x8 cf[8];
#pragma unroll
        for (int ks = 0; ks < 8; ++ks) cf[ks] = *(const LAS bf16x8*)(Ctok + (ib * 32 + r32) * SP + ks * 32 + h * 16);
        f32x16 ao[2], ay[2];
#pragma unroll
        for (int pb = 0; pb < 2; ++pb) { ao[pb] = (f32x16){0.f, 0.f, 0.f, 0.f, 0.f, 0.f, 0.f, 0.f, 0.f, 0.f, 0.f, 0.f, 0.f, 0.f, 0.f, 0.f}; ay[pb] = ao[pb]; }
#pragma unroll
        for (int pb = 0; pb < 2; ++pb) { const bf16* hp = HPREV + ((size_t)((b * 32 + c) * 8 + hd) * 64 + pb * 32 + r32) * 128 + h * 8;
#pragma unroll
            for (int ks = 0; ks < 8; ++ks) { const bf16x8 hv = *(const bf16x8*)(hp + ks * 16); ao[pb] = __builtin_amdgcn_mfma_f32_32x32x16_bf16(cf[ks], hv, ao[pb], 0, 0, 0); } }
        const float cs_i = csr[ib * 32 + r32];
#pragma unroll 1
        for (int jb = 0; jb <= ib; ++jb) {
            f32x16 gt = (f32x16){0.f, 0.f, 0.f, 0.f, 0.f, 0.f, 0.f, 0.f, 0.f, 0.f, 0.f, 0.f, 0.f, 0.f, 0.f, 0.f};
            const LAS unsigned char* bq = Btok + (jb * 32 + r32) * SP + h * 16;
#pragma unroll
            for (int ks = 0; ks < 8; ++ks) { const bf16x8 bf = *(const LAS bf16x8*)(bq + ks * 32); gt = __builtin_amdgcn_mfma_f32_32x32x16_bf16(bf, cf[ks], gt, 0, 0, 0); }
            float mv[16]; const LAS float* csj = csr + jb * 32 + 4 * h; const LAS float* dtj = dtr + jb * 32 + 4 * h; const int irel = (ib - jb) * 32 + r32 - 4 * h;
#pragma unroll
            for (int reg = 0; reg < 16; ++reg) { const int jo = (reg & 3) + 8 * (reg >> 2);
                const float e = __expf(cs_i - csj[jo]) * dtj[jo]; mv[reg] = (jo <= irel) ? gt[reg] * e : 0.f; }
            const bf16x8 mf0 = pack8(mv[0], mv[1], mv[2], mv[3], mv[4], mv[5], mv[6], mv[7]), mf1 = pack8(mv[8], mv[9], mv[10], mv[11], mv[12], mv[13], mv[14], mv[15]);
#pragma unroll
            for (int pb = 0; pb < 2; ++pb) { const LAS unsigned char* xp = XT + (r * 64 + pb * 32 + r32) * SP + (jb * 32 + 4 * h) * 2;
                typedef u64 u64x2 __attribute__((ext_vector_type(2)));
                const u64x2 x0 = {*(const LAS u64*)xp, *(const LAS u64*)(xp + 16)}, x1 = {*(const LAS u64*)(xp + 32), *(const LAS u64*)(xp + 48)};
                ay[pb] = __builtin_amdgcn_mfma_f32_32x32x16_bf16(mf0, __builtin_bit_cast(bf16x8, x0), ay[pb], 0, 0, 0);
                ay[pb] = __builtin_amdgcn_mfma_f32_32x32x16_bf16(mf1, __builtin_bit_cast(bf16x8, x1), ay[pb], 0, 0, 0); }
        }
        const LAS float* csi = csr + ib * 32 + 4 * h;
        const LAS unsigned char* xq = XT + (r * 64 + r32) * SP + (ib * 32 + 4 * h) * 2;
        const bf16* zp = PROJ + (size_t)(m0 + ib * 32 + 4 * h) * NPROJ + C_Z + g * 256 + r * 64 + r32;
#pragma unroll
        for (int reg = 0; reg < 16; ++reg) { const int io = (reg & 3) + 8 * (reg >> 2); const float ecs = __expf(csi[io]); float s = 0.f;
#pragma unroll
            for (int pb = 0; pb < 2; ++pb) { const float xs = bf2f(*(const LAS unsigned short*)(xq + pb * 32 * SP + io * 2));
                const float y = ay[pb][reg] + ecs * ao[pb][reg] + Dv * xs;
                const float z = bf2f(zp[(size_t)io * NPROJ + pb * 32]);
                const float v = y * silu_fast(z); vkeep[ibk][pb][reg] = v; s += v * v; }
            s += __shfl_xor(s, 1); s += __shfl_xor(s, 2); s += __shfl_xor(s, 4); s += __shfl_xor(s, 8); s += __shfl_xor(s, 16);
            if (r32 == 0) RSQ[r * 128 + ib * 32 + 4 * h + io] = s; }
    }
    __syncthreads();
#pragma unroll
    for (int ibk = 0; ibk < 2; ++ibk) { const int ib = sel ? (1 + ibk) : (3 * ibk);
        const LAS float* rq = RSQ + ib * 32 + 4 * h;
        bf16* op = MIX + (size_t)(m0 + ib * 32 + 4 * h) * 1024 + 512 + g * 256 + r * 64 + r32;
        const float w0 = nw[g * 256 + r * 64 + r32], w1 = nw[g * 256 + r * 64 + 32 + r32];
#pragma unroll
        for (int reg = 0; reg < 16; ++reg) { const int io = (reg & 3) + 8 * (reg >> 2);
            const float tot = (rq[io] + rq[128 + io]) + (rq[256 + io] + rq[384 + io]); const float rstd = 1.0f / sqrtf(tot * (1.0f / 256.0f) + EPS);
            op[(size_t)io * 1024] = (bf16)f2bf(vkeep[ibk][0][reg] * rstd * w0); op[(size_t)io * 1024 + 32] = (bf16)f2bf(vkeep[ibk][1][reg] * rstd * w1); } }
    __syncthreads();
}

__device__ __forceinline__ void ssm_sample_unit(Frame& F, int b, int g) {
    const bf16* PROJ = (const bf16*)(F.ws + WS_PROJ); const float* DT = (const float*)(F.ws + WS_DT); bf16* MIX = (bf16*)(F.ws + WS_MIX);
    const float* sconv = F.in[4]; const float* st0 = F.in[5]; const float* cw = F.in[10]; const float* cb = F.in[11]; const float* A_log = F.in[13]; const float* Dsk = F.in[14]; const float* nw = F.in[15];
    LAS float* XS = (LAS float*)F.lds; LAS float* BS = XS + 256; LAS float* CSm = BS + 128; LAS float* YL = CSm + 128; LAS float* RED = YL + 256;
    const int tid = F.tid, lane = F.lane, wave = F.wave; const size_t m = MPROMPT + b;
    {
        const int chx = tid < 256 ? g * 256 + tid : (tid < 384 ? 512 + g * 128 + (tid - 256) : 768 + g * 128 + (tid - 384));
        float a = cb[chx];
#pragma unroll
        for (int j = 0; j < 3; ++j) a += cw[j * 1024 + chx] * sconv[(size_t)b * 3072 + j * 1024 + chx];
        a += cw[3072 + chx] * bf2f(PROJ[m * NPROJ + C_XBC + chx]);
        XS[tid] = silu_fast(a); }
    __syncthreads();
    const int hl = lane >> 5, l32 = lane & 31;
#pragma unroll 1
    for (int it = 0; it < 16; ++it) { const int row = wave * 32 + it * 2 + hl, r = row >> 6, p = row & 63, hd = 4 * g + r;
        const float dt = DT[m * 8 + hd], A = -expf(A_log[hd]), dA = __expf(dt * A), x = XS[row], dx = dt * x;
        const size_t so = ((size_t)((b * 8 + hd) * 64 + p)) * 128 + 4 * l32;
        f32x4 hv = *(const f32x4*)(st0 + so); const f32x4 bv = *(const LAS f32x4*)(BS + 4 * l32), cv = *(const LAS f32x4*)(CSm + 4 * l32);
        hv = hv * dA + bv * dx; *(f32x4*)(F.out + O_SS + so) = hv;
        float y = (hv[0] * cv[0] + hv[1] * cv[1]) + (hv[2] * cv[2] + hv[3] * cv[3]);
        y += __shfl_xor(y, 1); y += __shfl_xor(y, 2); y += __shfl_xor(y, 4); y += __shfl_xor(y, 8); y += __shfl_xor(y, 16);
        if (l32 == 0) YL[row] = y + Dsk[hd] * x; }
    __syncthreads();
    float v = 0.f;
    if (tid < 256) { const float z = bf2f(PROJ[m * NPROJ + C_Z + g * 256 + tid]); v = YL[tid] * silu_fast(z); }
    const float ws = wave_sum(v * v); if (lane == 0) RED[wave] = ws;
    __syncthreads();
    if (tid < 256) { const float tot = (RED[0] + RED[1]) + (RED[2] + RED[3]); const float rstd = 1.0f / sqrtf(tot * (1.0f / 256.0f) + EPS);
        MIX[m * 1024 + 512 + g * 256 + tid] = (bf16)f2bf(v * rstd * nw[g * 256 + tid]); }
    __syncthreads();
}
__device__ __forceinline__ void copy_small_outputs(Frame& F) {
    const bf16* PROJ = (const bf16*)(F.ws + WS_PROJ);
    const int gt = F.vcu * NWAVES * 64 + F.tid, NGT = F.G * NWAVES * 64;
    for (int i = gt; i < BATCH * 128 * 128; i += NGT) { const int c = i & 127, j = (i >> 7) & 127, b = i >> 14; const size_t row = (size_t)b * SEQ + (SEQ - 128) + j;
        F.out[O_KP + i] = bf2f(PROJ[row * NPROJ + C_K + c]); F.out[O_VP + i] = bf2f(PROJ[row * NPROJ + C_V + c]); }
    for (int i = gt; i < BATCH * 3 * 1024; i += NGT) { const int c = i & 1023, j = (i >> 10) % 3, b = i / 3072; F.out[O_CP + i] = bf2f(PROJ[((size_t)b * SEQ + SEQ - 3 + j) * NPROJ + C_XBC + c]); }
    for (int i = gt; i < NB * 128; i += NGT) { const int c = i & 127, b = i >> 7; const size_t row = MPROMPT + b;
        F.out[O_KS + (size_t)b * 16384 + 127 * 128 + c] = bf2f(PROJ[row * NPROJ + C_K + c]); F.out[O_VS + (size_t)b * 16384 + 127 * 128 + c] = bf2f(PROJ[row * NPROJ + C_V + c]); }
    for (int i = gt; i < NB * 1024; i += NGT) { const int c = i & 1023, b = i >> 10; F.out[O_CS + (size_t)b * 3072 + 2048 + c] = bf2f(PROJ[(size_t)(MPROMPT + b) * NPROJ + C_XBC + c]); }
}
__device__ __forceinline__ void p8_final_norm(Frame& F) {
    const float* wf = F.in[21];
    const int gw = F.vcu * NWAVES + F.wave, NGW = F.G * NWAVES;
    f32x4 w[4];
#pragma unroll
    for (int j = 0; j < 4; ++j) w[j] = ((const f32x4*)wf)[64 * j + F.lane];
    for (int m = gw; m < MREAL; m += NGW) { f32x4* xr = (f32x4*)(F.out + (size_t)m * DM) + F.lane; f32x4 v[4]; float s = 0.f;
#pragma unroll
        for (int j = 0; j < 4; ++j) { v[j] = xr[64 * j]; s += (v[j][0] * v[j][0] + v[j][1] * v[j][1]) + (v[j][2] * v[j][2] + v[j][3] * v[j][3]); }
        const float rstd = 1.0f / sqrtf(wave_sum(s) * (1.0f / DM) + EPS);
#pragma unroll
        for (int j = 0; j < 4; ++j) xr[64 * j] = v[j] * rstd * w[j]; }
}

struct Args { const float* in[22]; float* out; unsigned char* ws; int ph_lo, ph_hi; };
constexpr int N_PHASES = 9;
#ifndef MK_ONE_LAUNCH
#define MK_ONE_LAUNCH 1
#endif
__global__ void __launch_bounds__(NWAVES * 64, 2) hymba_fwd(Args args) {
    extern __shared__ __attribute__((aligned(16))) unsigned char lds[];
    Frame F;
    F.lds = (LAS unsigned char*)lds;
    F.tid = threadIdx.x; F.lane = F.tid & 63; F.wave = __builtin_amdgcn_readfirstlane(F.tid >> 6);
    F.G = gridDim.x; { const int bx = blockIdx.x; F.vcu = (F.G % 8 == 0) ? (bx % 8) * (F.G / 8) + bx / 8 : bx; }
#pragma unroll
    for (int i = 0; i < 22; ++i) F.in[i] = args.in[i];
    F.out = args.out; F.ws = args.ws;
    volatile LAS unsigned* MISC = (volatile LAS unsigned*)(F.lds + MISC_OFF);
    if (F.tid < 64) MISC[F.tid] = 0u;
    __syncthreads();
    gu32* ctl = (gu32*)(F.ws + WS_CTL);
    XcdBarrier bar; bar.bar = (unsigned*)(ctl + CW_BAR); bar.x = 0; bar.st = nullptr;
    const int lo = args.ph_lo, hi = args.ph_hi;
    if (hi - lo > 1) bar = xcd_barrier_post((unsigned*)(ctl + CW_BAR), MISC + 8);
#define IN(k) (lo <= (k) && (k) < hi)
#define SEAM(k) do { if (IN(k) && IN((k) + 1)) xcd_barrier(bar); } while (0)
    bf16* XN = (bf16*)(F.ws + WS_XN); bf16* PROJ = (bf16*)(F.ws + WS_PROJ); bf16* MIX = (bf16*)(F.ws + WS_MIX); bf16* HB = (bf16*)(F.ws + WS_PROJ);
    float* SSQ1 = (float*)(F.ws + WS_SSQ1);
    if (IN(0)) { p0_prologue(F); SEAM(0); }
    if (IN(1)) {
        pg8::Gemm g{XN, (const bf16*)(F.ws + WS_WIN), MP, NPROJ, DM}; pg8::StaticOrder S; S.init(MP, NPROJ, F.G, (int)blockIdx.x);
        pg8::EpiStoreBf16 E{PROJ, NPROJ};
        pg8::gemm_phase<pg8::EpiStoreBf16, pg8::StaticOrder, true, true>(F.lds + RING_OFF, g, S, E);
        SEAM(1);
    }
    if (IN(2)) { for (int u = F.vcu; u < 256; u += F.G) { ssd_part1_unit(F, u >> 6, (u >> 1) & 31, u & 1); attn_unit(F, u >> 6, (u >> 1) & 31, u & 1); } copy_small_outputs(F); SEAM(2); }
    if (IN(3)) { ssd_scan(F); for (int u = F.vcu; u < 256; u += F.G) ssm_sample_unit(F, u >> 1, u & 1); p3_attn_naive(F, MPROMPT); SEAM(3); }
    if (IN(4)) { for (int u = F.vcu; u < 256; u += F.G) ssd_part2_unit(F, u >> 6, (u >> 1) & 31, u & 1); SEAM(4); }
    if (IN(5)) {
        pg8::Gemm g{MIX, (const bf16*)(F.ws + WS_WOUT), MP, DM, DM}; pg8::StaticOrder S; S.init(MP, DM, F.G, (int)blockIdx.x);
        pg8::EpiResid E{F.in[0], F.in[1], MPROMPT, F.out, XN, SSQ1, MREAL};
        pg8::gemm_phase<pg8::EpiResid, pg8::StaticOrder, true, true>(F.lds + RING_OFF, g, S, E);
        SEAM(5);
    }
    if (IN(6)) {
        pg8::Gemm g{XN, (const bf16*)(F.ws + WS_WGU), MP, NGU, DM}; pg8::StaticOrder S; S.init(MP, NGU, F.G, (int)blockIdx.x);
        pg8::EpiSwiglu E{HB, DFF, SSQ1, EPS};
        pg8::gemm_phase<pg8::EpiSwiglu, pg8::StaticOrder, true, true>(F.lds + RING_OFF, g, S, E);
        SEAM(6);
    }
    if (IN(7)) {
        pg8::Gemm g{HB, (const bf16*)(F.ws + WS_WD), MP, DM, DFF}; pg8::StaticOrder S; S.init(MP, DM, F.G, (int)blockIdx.x);
        pg8::EpiResid E{F.out, F.out, MP, F.out, nullptr, nullptr, MREAL};
        pg8::gemm_phase<pg8::EpiResid, pg8::StaticOrder, true, true>(F.lds + RING_OFF, g, S, E);
        SEAM(7);
    }
    if (IN(8)) { p8_final_norm(F); }
#undef IN
#undef SEAM
}

extern "C" void kernel_launch(void* const* d_in, const int* in_sizes, int n_in, void* d_out, int out_size, void* d_ws, size_t ws_size, hipStream_t stream) {
    static int grid = 0;
    if (grid == 0) {
        if (n_in != 22 || (size_t)out_size != O_END || ws_size < WS_END) { fprintf(stderr, "kernel_launch: unexpected shapes (n_in %d out %d ws %zu)\n", n_in, out_size, ws_size); grid = -1; return; }
        int dev = 0, cus = 0;
        if (hipGetDevice(&dev) != hipSuccess || hipDeviceGetAttribute(&cus, hipDeviceAttributeMultiprocessorCount, dev) != hipSuccess) { grid = -1; return; }
        if (hipFuncSetAttribute((const void*)hymba_fwd, hipFuncAttributeMaxDynamicSharedMemorySize, LDS_BYTES) != hipSuccess) { fprintf(stderr, "kernel_launch: hipFuncSetAttribute failed\n"); grid = -1; return; }
        int per_cu = 0;
        if (hipOccupancyMaxActiveBlocksPerMultiprocessor(&per_cu, (const void*)hymba_fwd, NWAVES * 64, LDS_BYTES) != hipSuccess || per_cu < 1) fprintf(stderr, "kernel_launch: occupancy query reports %d\n", per_cu);
        (void)hipGetLastError();
        grid = cus;
    }
    if (grid < 0) return;
    if (hipMemsetAsync((char*)d_ws + WS_CTL, 0, CTL_ZERO_BYTES, stream) != hipSuccess) return;
    Args a{};
    for (int i = 0; i < 22; ++i) a.in[i] = (const float*)d_in[i];
    a.out = (float*)d_out; a.ws = (unsigned char*)d_ws;
#if MK_ONE_LAUNCH
    a.ph_lo = 0; a.ph_hi = N_PHASES;
    hipLaunchKernelGGL(hymba_fwd, dim3(grid), dim3(NWAVES * 64), LDS_BYTES, stream, a);
#else
    for (int p = 0; p < N_PHASES; ++p) { a.ph_lo = p; a.ph_hi = p + 1; hipLaunchKernelGGL(hymba_fwd, dim3(grid), dim3(NWAVES * 64), LDS_BYTES, stream, a); }
#endif
}
```

```cpp
#include <hip/hip_runtime.h>
#include <cstdio>
#include <cstdint>
namespace pg8 {
#define PG8_LAS __attribute__((address_space(3)))
typedef unsigned short bf16_t;
typedef short bf16x8 __attribute__((ext_vector_type(8)));
typedef float f32x4 __attribute__((ext_vector_type(4)));
typedef unsigned u32x4 __attribute__((ext_vector_type(4)));
constexpr int BM = 256, BK = 64, HALF = 128, HTB = HALF * BK * 2  , STAGE_BYTES = 8 * HTB, NXCD = 8, WGM = 8;

__host__ __device__ __forceinline__ int lds_byte(int r, int c) { const int st = (r >> 4) * 2 + (c >> 5), rr = r & 15, cc = c & 31, ob = rr * 64 + cc * 2; return st * 1024 + (ob ^ (((ob >> 9) & 1) << 5)); }
__host__ __device__ __forceinline__ void stage_rc(int b, int& R, int& C) { const int st = b / 1024, sb = b % 1024, swz = sb ^ (((sb >> 9) & 1) << 5); R = (st >> 1) * 16 + swz / 64; C = (st & 1) * 32 + (swz % 64) / 2; }
__host__ __device__ __forceinline__ int perm32(int rho) { const int n = rho >> 4, i = rho & 15; return 8 * (i >> 2) + 4 * n + (i & 3); }

struct Unit { int pm, pn; };
struct Gemm { const bf16_t* A; const bf16_t* Bt; int M, N, K; };

struct StaticOrder {
    int nM, nN, nwg, G, c;
    __host__ __device__ void init(int M, int N, int G_, int c_) { nM = M / BM; nN = N / BM; nwg = nM * nN; G = G_; c = c_; }
    __host__ __device__ bool next(int i, Unit& u) const {
        const long L = (long)i * G + c; if (L >= nwg) return false;
        int wgid = (int)L; { const int q = nwg / NXCD, r = nwg % NXCD, xcd = wgid % NXCD, off = wgid / NXCD; wgid = (xcd < r ? xcd * (q + 1) : r * (q + 1) + (xcd - r) * q) + off; }
        const int nig = WGM * nN, gid = wgid / nig, fm = gid * WGM, gsz = (nM - fm) < WGM ? (nM - fm) : WGM;
        u.pm = fm + ((wgid % nig) % gsz); u.pn = (wgid % nig) / gsz; return true;
    }
    __device__ __forceinline__ void a_ready(const Unit&) const {}
    __device__ __forceinline__ void done(const Unit&) const {}
};

__device__ __forceinline__ unsigned cvt_pk_bf16(float lo, float hi) { unsigned r; asm volatile("v_cvt_pk_bf16_f32 %0, %1, %2" : "=v"(r) : "v"(lo), "v"(hi)); return r; }
typedef unsigned u32x2 __attribute__((ext_vector_type(2)));
struct EpiStoreBf16 {
    static constexpr bool PERM = true, AFTER_DRAIN = false;
    bf16_t* O; int ldc;
    __device__ __forceinline__ void operator()(const f32x4 (&acc)[2][2][4][2], const Unit& u, int wr, int wc, int fr, int fq) const {
        const int row0 = u.pm * BM + wr * 64 + fr, col0 = u.pn * BM + wc * 32 + 8 * fq;
#pragma unroll
        for (int ai = 0; ai < 2; ++ai)
#pragma unroll
            for (int m = 0; m < 4; ++m) { bf16_t* rowp = O + (size_t)(row0 + ai * HALF + m * 16) * ldc + col0;
#pragma unroll
                for (int bj = 0; bj < 2; ++bj) { const f32x4 v0 = acc[ai][bj][m][0], v1 = acc[ai][bj][m][1];
                    u32x4 w; w.x = cvt_pk_bf16(v0[0], v0[1]); w.y = cvt_pk_bf16(v0[2], v0[3]); w.z = cvt_pk_bf16(v1[0], v1[1]); w.w = cvt_pk_bf16(v1[2], v1[3]);
                    *(u32x4*)(rowp + bj * HALF) = w; } }
    }
};
struct EpiResid {
    static constexpr bool PERM = false, AFTER_DRAIN = false;
    const float* base0; const float* base1; int split; float* out; bf16_t* xb; float* ssq; int mreal;
    __device__ __forceinline__ void operator()(const f32x4 (&acc)[2][2][4][2], const Unit& u, int wr, int wc, int fr, int fq) const {
        const int col0 = u.pn * BM + wc * 32 + 4 * fq;
#pragma unroll
        for (int ai = 0; ai < 2; ++ai)
#pragma unroll
            for (int m = 0; m < 4; ++m) { const int row = u.pm * BM + ai * HALF + wr * 64 + m * 16 + fr;
                float s = 0.f;
                if (row < mreal) {
                    const float* bp = (row < split ? base0 + (size_t)row * 1024 : base1 + (size_t)(row - split) * 1024) + col0;
                    float* op = out + (size_t)row * 1024 + col0;
#pragma unroll
                    for (int bj = 0; bj < 2; ++bj)
#pragma unroll
                        for (int n = 0; n < 2; ++n) { const f32x4 v = *(const f32x4*)(bp + bj * HALF + n * 16) + acc[ai][bj][m][n];
                            *(f32x4*)(op + bj * HALF + n * 16) = v; s += (v[0] * v[0] + v[1] * v[1]) + (v[2] * v[2] + v[3] * v[3]);
                            if (xb) { u32x2 w; w.x = cvt_pk_bf16(v[0], v[1]); w.y = cvt_pk_bf16(v[2], v[3]); *(u32x2*)(xb + (size_t)row * 1024 + col0 + bj * HALF + n * 16) = w; } }
                }
                if (ssq) { s += __shfl_xor(s, 16); s += __shfl_xor(s, 32); if (fq == 0 && row < mreal) ssq[(size_t)row * 16 + u.pn * 4 + wc] = s; }
            }
    }
};
struct EpiSwiglu {
    static constexpr bool PERM = true, AFTER_DRAIN = false;
    bf16_t* H; int ldh; const float* ssq; float eps;
    __device__ __forceinline__ void operator()(const f32x4 (&acc)[2][2][4][2], const Unit& u, int wr, int wc, int fr, int fq) const {
        const int row0 = u.pm * BM + wr * 64 + fr, hcol0 = (u.pn * BM + wc * 32 + 8 * fq) >> 1;
#pragma unroll
        for (int ai = 0; ai < 2; ++ai)
#pragma unroll
            for (int m = 0; m < 4; ++m) { const int row = row0 + ai * HALF + m * 16;
                const f32x4* sp = (const f32x4*)(ssq + (size_t)row * 16); const f32x4 s0 = sp[0], s1 = sp[1], s2 = sp[2], s3 = sp[3];
                const float sum = ((s0[0] + s0[1]) + (s0[2] + s0[3])) + ((s1[0] + s1[1]) + (s1[2] + s1[3])) + ((s2[0] + s2[1]) + (s2[2] + s2[3])) + ((s3[0] + s3[1]) + (s3[2] + s3[3]));
                const float rstd = 1.0f / sqrtf(sum * (1.0f / 1024.0f) + eps);
#pragma unroll
                for (int bj = 0; bj < 2; ++bj) { const f32x4 g = acc[ai][bj][m][0] * rstd, up = acc[ai][bj][m][1] * rstd; float hv[4];
#pragma unroll
                    for (int e = 0; e < 4; ++e) hv[e] = g[e] * __builtin_amdgcn_rcpf(1.0f + __expf(-g[e])) * up[e];
                    u32x2 w; w.x = cvt_pk_bf16(hv[0], hv[1]); w.y = cvt_pk_bf16(hv[2], hv[3]);
                    *(u32x2*)(H + (size_t)row * ldh + hcol0 + bj * (HALF / 2)) = w; } }
    }
};
template <class Epi, class Sched, bool ALIGN_EPI = false, bool SP2 = false>
__device__ __forceinline__ void gemm_phase(PG8_LAS unsigned char* lds, const Gemm g, const Sched& S, const Epi& E) {
    const int tid = threadIdx.x, wid = __builtin_amdgcn_readfirstlane(tid >> 6), lane = tid & 63, wr = wid >> 2, wc = wid & 3, fr = lane & 15, fq = lane >> 4;
    const int K = g.K, nt = K / BK;
    unsigned voffA[2], voffB[2];
#pragma unroll
    for (int i = 0; i < 2; ++i) { int R, C; stage_rc(tid * 16 + i * 8192, R, C); const int Rb = Epi::PERM ? ((R & ~31) + perm32(R & 31)) : R;
        voffA[i] = (unsigned)(R * K + C) * 2u; voffB[i] = (unsigned)(Rb * K + C) * 2u; }
    const size_t kstep = (size_t)(BK * 2);
    const size_t hstep = (size_t)HALF * K * 2;
    const size_t tstep = 2 * hstep;
    const unsigned ldsw = (unsigned)wid * 1024u;
    const int aoff = lds_byte(wr * 64 + fr, fq * 8), boff = lds_byte(wc * 32 + fr, fq * 8);
#define PG8_SA(b, h) (((b) * 2 + (h)) * HTB)
#define PG8_SB(b, h) ((4 + (b) * 2 + (h)) * HTB)
#define PG8_STAGE(bufoff, gbase, voff) do { _Pragma("unroll") for (int _i = 0; _i < 2; ++_i) \
        __builtin_amdgcn_global_load_lds((const unsigned*)((const char*)(gbase) + (voff)[_i]), (PG8_LAS unsigned*)(lds + (bufoff) + ldsw + _i * 8192), 16, 0, 0); } while (0)
#define PG8_LDA(dst, b, h) do { _Pragma("unroll") for (int m = 0; m < 4; ++m) _Pragma("unroll") for (int k = 0; k < 2; ++k) dst[m][k] = *(const PG8_LAS bf16x8*)(lds + PG8_SA(b, h) + aoff + m * 2048 + k * 1024); } while (0)
#define PG8_LDB(dst, b, h) do { _Pragma("unroll") for (int n = 0; n < 2; ++n) _Pragma("unroll") for (int k = 0; k < 2; ++k) dst[n][k] = *(const PG8_LAS bf16x8*)(lds + PG8_SB(b, h) + boff + n * 2048 + k * 1024); } while (0)
#define PG8_MMA(ai, bj, At, Bt) do { __builtin_amdgcn_s_setprio(1); _Pragma("unroll") for (int m = 0; m < 4; ++m) _Pragma("unroll") for (int n = 0; n < 2; ++n) _Pragma("unroll") for (int k = 0; k < 2; ++k) \
        acc[ai][bj][m][n] = __builtin_amdgcn_mfma_f32_16x16x32_bf16(Bt[n][k], At[m][k], acc[ai][bj][m][n], 0, 0, 0); __builtin_amdgcn_s_setprio(0); } while (0)
#define PG8_WAIT_V(n) asm volatile("s_waitcnt vmcnt(" #n ")" ::: "memory")
#define PG8_WAIT_L(n) asm volatile("s_waitcnt lgkmcnt(" #n ")" ::: "memory")
#define PG8_BAR __builtin_amdgcn_s_barrier()
#define PG8_SCHED __builtin_amdgcn_sched_barrier(0)
    Unit cur, nxt; int ui = 0;
    if (!S.next(0, cur)) return;
    f32x4 acc[2][2][4][2];
#pragma unroll
    for (int a = 0; a < 2; ++a)
#pragma unroll
        for (int b = 0; b < 2; ++b)
#pragma unroll
            for (int m = 0; m < 4; ++m)
#pragma unroll
                for (int n = 0; n < 2; ++n) acc[a][b][m][n] = (f32x4){0.f, 0.f, 0.f, 0.f};
    bf16x8 At[4][2], B0[2][2], B1[2][2];
    const char* cA = (const char*)g.A + (size_t)cur.pm * tstep; const char* cB = (const char*)g.Bt + (size_t)cur.pn * tstep;
    S.a_ready(cur);
    if constexpr (SP2) {
        PG8_STAGE(PG8_SB(0, 0), cB, voffB); PG8_STAGE(PG8_SB(0, 1), cB + hstep, voffB); PG8_STAGE(PG8_SA(0, 0), cA, voffA); PG8_STAGE(PG8_SA(0, 1), cA + hstep, voffA);
        if (wr == 1) PG8_BAR;
        PG8_WAIT_V(2); PG8_BAR;
        PG8_STAGE(PG8_SB(1, 0), cB + kstep, voffB); PG8_STAGE(PG8_SA(1, 0), cA + kstep, voffA); PG8_STAGE(PG8_SB(1, 1), cB + hstep + kstep, voffB);
        PG8_WAIT_V(6); PG8_BAR;
    } else {
        PG8_STAGE(PG8_SB(0, 0), cB, voffB); PG8_STAGE(PG8_SA(0, 0), cA, voffA); PG8_STAGE(PG8_SB(0, 1), cB + hstep, voffB); PG8_STAGE(PG8_SA(0, 1), cA + hstep, voffA);
        if (wr == 1) PG8_BAR;
        PG8_WAIT_V(4); PG8_BAR;
        PG8_STAGE(PG8_SB(1, 0), cB + kstep, voffB); PG8_STAGE(PG8_SA(1, 0), cA + kstep, voffA); PG8_STAGE(PG8_SB(1, 1), cB + hstep + kstep, voffB);
        PG8_WAIT_V(6); PG8_BAR;
    }
    for (;;) {
        const bool has_next = S.next(ui + 1, nxt);
        const char* nA = has_next ? (const char*)g.A + (size_t)nxt.pm * tstep : cA; const char* nB = has_next ? (const char*)g.Bt + (size_t)nxt.pn * tstep : cB;
        for (int t = 0; t < nt; t += 2) {
            const bool last = (t == nt - 2);
            const char* a1 = cA + (size_t)(t + 1) * kstep;
            const char* a2 = last ? nA : cA + (size_t)(t + 2) * kstep; const char* b2 = last ? nB : cB + (size_t)(t + 2) * kstep;
            const char* a3 = a2 + kstep; const char* b3 = b2 + kstep;
            if (last && has_next) S.a_ready(nxt);
            if constexpr (SP2) {
            PG8_LDB(B0, 0, 0); PG8_LDB(B1, 0, 1); PG8_SCHED; PG8_LDA(At, 0, 0); PG8_STAGE(PG8_SA(1, 1), a1 + hstep, voffA);
            PG8_WAIT_V(8); PG8_WAIT_L(0); PG8_BAR; PG8_MMA(0, 0, At, B0); PG8_MMA(0, 1, At, B1); PG8_BAR; PG8_SCHED;
            PG8_LDA(At, 0, 1); PG8_STAGE(PG8_SB(0, 0), b2, voffB); PG8_STAGE(PG8_SB(0, 1), b2 + hstep, voffB); PG8_STAGE(PG8_SA(0, 0), a2, voffA);
            PG8_WAIT_V(8); PG8_WAIT_L(0); PG8_BAR; PG8_MMA(1, 0, At, B0); PG8_MMA(1, 1, At, B1); PG8_BAR; PG8_SCHED;
            PG8_LDB(B0, 1, 0); PG8_LDB(B1, 1, 1); PG8_SCHED; PG8_LDA(At, 1, 0); PG8_STAGE(PG8_SA(0, 1), a2 + hstep, voffA);
            PG8_WAIT_V(8); PG8_WAIT_L(0); PG8_BAR; PG8_MMA(0, 0, At, B0); PG8_MMA(0, 1, At, B1); PG8_BAR; PG8_SCHED;
            PG8_LDA(At, 1, 1); PG8_STAGE(PG8_SB(1, 0), b3, voffB); PG8_STAGE(PG8_SB(1, 1), b3 + hstep, voffB); PG8_STAGE(PG8_SA(1, 0), a3, voffA);
            PG8_WAIT_V(8); PG8_WAIT_L(0); PG8_BAR; PG8_MMA(1, 0, At, B0); PG8_MMA(1, 1, At, B1); PG8_BAR; PG8_SCHED;
            } else {
            PG8_LDB(B0, 0, 0); PG8_SCHED; PG8_LDA(At, 0, 0); PG8_STAGE(PG8_SA(1, 1), a1 + hstep, voffA);
            PG8_WAIT_L(8); PG8_BAR; PG8_WAIT_L(0); PG8_MMA(0, 0, At, B0); PG8_BAR; PG8_SCHED;
            PG8_LDB(B1, 0, 1); PG8_STAGE(PG8_SB(0, 0), b2, voffB);
            PG8_BAR; PG8_WAIT_L(0); PG8_MMA(0, 1, At, B1); PG8_BAR;
            PG8_LDA(At, 0, 1); PG8_STAGE(PG8_SA(0, 0), a2, voffA);
            PG8_BAR; PG8_WAIT_L(0); PG8_MMA(1, 0, At, B0); PG8_BAR; PG8_SCHED;
            PG8_STAGE(PG8_SB(0, 1), b2 + hstep, voffB);
            PG8_WAIT_V(6); PG8_BAR; PG8_MMA(1, 1, At, B1); PG8_BAR;
            PG8_LDB(B0, 1, 0); PG8_SCHED; PG8_LDA(At, 1, 0); PG8_STAGE(PG8_SA(0, 1), a2 + hstep, voffA);
            PG8_WAIT_L(8); PG8_BAR; PG8_WAIT_L(0); PG8_MMA(0, 0, At, B0); PG8_BAR; PG8_SCHED;
            PG8_LDB(B1, 1, 1); PG8_STAGE(PG8_SB(1, 0), b3, voffB);
            PG8_BAR; PG8_WAIT_L(0); PG8_MMA(0, 1, At, B1); PG8_BAR;
            PG8_LDA(At, 1, 1); PG8_STAGE(PG8_SA(1, 0), a3, voffA);
            PG8_BAR; PG8_WAIT_L(0); PG8_MMA(1, 0, At, B0); PG8_BAR; PG8_SCHED;
            PG8_STAGE(PG8_SB(1, 1), b3 + hstep, voffB);
            PG8_WAIT_V(6); PG8_BAR; PG8_MMA(1, 1, At, B1); PG8_BAR;
            }
        }
        if constexpr (ALIGN_EPI) { if (wr == 0) PG8_BAR; }
        if constexpr (!Epi::AFTER_DRAIN) { E(acc, cur, wr, wc, fr, fq); S.done(cur); }
        if (!has_next) break;
#pragma unroll
        for (int a = 0; a < 2; ++a)
#pragma unroll
            for (int b = 0; b < 2; ++b)
#pragma unroll
                for (int m = 0; m < 4; ++m)
#pragma unroll
                    for (int n = 0; n < 2; ++n) acc[a][b][m][n] = (f32x4){0.f, 0.f, 0.f, 0.f};
        cur = nxt; cA = nA; cB = nB; ++ui;
        if constexpr (ALIGN_EPI) { if (wr == 1) PG8_BAR; }
    }
    PG8_WAIT_V(0);
    if constexpr (!ALIGN_EPI) { if (wr == 0) PG8_BAR; }
    PG8_BAR;
    if constexpr (Epi::AFTER_DRAIN) { E.fused(acc, cur, wr, wc, fr, fq, lds, wid, lane); S.done(cur); }
#undef PG8_SA
#undef PG8_SB
#undef PG8_STAGE
#undef PG8_LDA
#undef PG8_LDB
#undef PG8_MMA
#undef PG8_WAIT_V
#undef PG8_WAIT_L
#undef PG8_BAR
#undef PG8_SCHED
}
}
#define GAS __attribute__((address_space(1)))
#define LAS __attribute__((address_space(3)))
typedef unsigned short bf16;
typedef unsigned v4u __attribute__((ext_vector_type(4)));
typedef float f32x4 __attribute__((ext_vector_type(4)));
typedef short bf16x8 __attribute__((ext_vector_type(8)));
typedef GAS unsigned gu32;
typedef GAS unsigned long long gu64;
#define RLX_AGENT __ATOMIC_RELAXED, __HIP_MEMORY_SCOPE_AGENT
#define LDS_WAIT() asm volatile("s_waitcnt lgkmcnt(0)" ::: "memory")
#define VM_WAIT() asm volatile("s_waitcnt vmcnt(0)" ::: "memory")
__device__ __forceinline__ unsigned long long rt() { return __builtin_amdgcn_s_memrealtime(); }
__device__ __forceinline__ unsigned f2bf(float f) { unsigned u = __builtin_bit_cast(unsigned, f); return (u + 0x7fffu + ((u >> 16) & 1u)) >> 16; }
__device__ __forceinline__ unsigned pk2(float lo, float hi) { return f2bf(lo) | (f2bf(hi) << 16); }

#define XB_TMO      128
#define XB_XCNT(j)  (256  + 64 * (j))
#define XB_XSUB(j)  (1280 + 64 * (j))
#define XB_XGEN(j)  (2304 + 64 * (j))
#define XB_TOP      3328
#define XB_TOPGEN   3392
#define XCD_BAR_WORDS 3456
#define XB_SPIN_CAP (1u << 18)

__device__ __forceinline__ unsigned xb_ld(unsigned* p)              { return __hip_atomic_load(p, __ATOMIC_RELAXED, __HIP_MEMORY_SCOPE_AGENT); }
__device__ __forceinline__ unsigned xb_add(unsigned* p, unsigned v) { return __hip_atomic_fetch_add(p, v, __ATOMIC_RELAXED, __HIP_MEMORY_SCOPE_AGENT); }
__device__ __forceinline__ unsigned xb_xcc_id() { return (unsigned)__builtin_amdgcn_s_getreg((3 << 11) | 20) & 0xFu; }
#define XB_SPIN(cond, bar) do { unsigned _sp = 0; while (cond) { __builtin_amdgcn_s_sleep(1); \
    if ((++_sp & 255u) == 0u) { if (xb_ld(&(bar)[XB_TMO])) break; if (_sp > XB_SPIN_CAP) { atomicAdd(&(bar)[XB_TMO], 1u); break; } } } } while (0)

struct XcdBarrier {
    unsigned* bar; unsigned x;
    volatile LAS unsigned* st;
};

__device__ __forceinline__ XcdBarrier xcd_barrier_post(unsigned* bar, volatile LAS unsigned* st) {
    XcdBarrier b; b.bar = bar; b.x = xb_xcc_id(); b.st = st;
    if (threadIdx.x == 0) (void)xb_add(&bar[XB_XCNT(b.x)], 1u);
    return b;
}
__device__ __forceinline__ void xcd_barrier_complete(unsigned* bar, unsigned x, unsigned& nloc, unsigned& nx) {
    const unsigned G = gridDim.x * gridDim.y * gridDim.z;
    unsigned sum, cnt, mine, sp = 0u;
    for (;;) {
        sum = 0u; cnt = 0u; mine = 0u;
#pragma unroll
        for (unsigned j = 0; j < 16; ++j) { const unsigned c = xb_ld(&bar[XB_XCNT(j)]); sum += c; cnt += (c > 0u) ? 1u : 0u; mine = (j == x) ? c : mine; }
        if (sum == G) break;
        __builtin_amdgcn_s_sleep(1);
        if ((++sp & 255u) == 0u) { if (xb_ld(&bar[XB_TMO])) break; if (sp > XB_SPIN_CAP) { atomicAdd(&bar[XB_TMO], 1u); break; } }
    }
    nloc = mine > 0u ? mine : 1u; nx = cnt > 0u ? cnt : 1u;
}

__device__ __forceinline__ void xcd_barrier(const XcdBarrier& b) {
    asm volatile("s_waitcnt vmcnt(0)" ::: "memory");
    __syncthreads();
    if (threadIdx.x == 0) {
        unsigned* bar = b.bar;
        __builtin_amdgcn_s_waitcnt(0);
        unsigned nloc = b.st[0], nx = b.st[1];
        if (nloc == 0u) { xcd_barrier_complete(bar, b.x, nloc, nx); b.st[0] = nloc; b.st[1] = nx; }
        const unsigned old = xb_add(&bar[XB_XSUB(b.x)], 1u);
        const unsigned gen = old / nloc;
        if (old + 1u == (gen + 1u) * nloc) {
            __builtin_amdgcn_fence(__ATOMIC_RELEASE, "agent");
            asm volatile("s_waitcnt vmcnt(0)" ::: "memory");
            const unsigned og = xb_add(&bar[XB_TOP], 1u);
            const unsigned tg = og / nx;
            if (og + 1u == (tg + 1u) * nx) xb_add(&bar[XB_TOPGEN], 1u);
            else XB_SPIN(xb_ld(&bar[XB_TOPGEN]) == tg, bar);
            __builtin_amdgcn_fence(__ATOMIC_ACQUIRE, "agent");
            xb_add(&bar[XB_XGEN(b.x)], 1u);
            asm volatile("s_waitcnt vmcnt(0)" ::: "memory");
        } else {
            XB_SPIN(xb_ld(&bar[XB_XGEN(b.x)]) == gen, bar);
            __builtin_amdgcn_fence(__ATOMIC_ACQUIRE, "agent");
            asm volatile("s_waitcnt vmcnt(0)" ::: "memory");
        }
    }
    __syncthreads();
}
constexpr int NWAVES = 8;
constexpr int DM = 1024, BATCH = 4, SEQ = 4096, NB = 128  , MPROMPT = BATCH * SEQ, MREAL = MPROMPT + NB, MP = 16640  ;
constexpr int NPROJ = 2304, LDW_IN = 2312, DFF = 2816, NGU = 2 * DFF;
constexpr int C_Q = 0, C_K = 512, C_V = 640, C_Z = 768, C_XBC = 1280, C_B = 1792, C_C = 2048;
constexpr float EPS = 1e-6f;
constexpr size_t O_YP = 0, O_YS = 16777216, O_KP = 16908288, O_VP = 16973824, O_CP = 17039360, O_SP = 17051648, O_KS = 17313792, O_VS = 19410944, O_CS = 21508096, O_SS = 21901312, O_END = 30289920;
constexpr size_t MiB = 1u << 20;
constexpr size_t WS_CTL = 0, CTL_ZERO_BYTES = 1 * MiB;
constexpr size_t WS_WIN = 2 * MiB;
constexpr size_t WS_WOUT = 7 * MiB;
constexpr size_t WS_WGU = 9 * MiB;
constexpr size_t WS_WD = 20 * MiB;
constexpr size_t WS_DT = 26 * MiB;
constexpr size_t WS_SSQ1 = 27 * MiB;
constexpr size_t WS_XN = 32 * MiB;
constexpr size_t WS_PROJ = 66 * MiB;
constexpr size_t WS_MIX = 140 * MiB;
constexpr size_t WS_YS = 174 * MiB;
constexpr size_t WS_XC = 208 * MiB;
constexpr size_t WS_END = 256 * MiB;
static_assert(WS_PROJ + (size_t)MP * DFF * 2 <= WS_YS && WS_XC + (size_t)MP * 1024 * 2 <= WS_END, "ws map");
constexpr int CW_BAR = 4096;

constexpr int RING_OFF = 0, RING_BYTES = 131072;
constexpr int LDS_BYTES = 163840;
constexpr int MISC_OFF = LDS_BYTES - 256;

__device__ const unsigned char BUCKET[128] = {0, 1, 2, 3, 4, 5, 6, 7, 8, 9, 10, 11, 12, 13, 14, 15, 16, 16, 16, 17, 17, 18, 18, 18, 19, 19, 19, 20, 20, 20, 20, 21, 21, 21, 21, 22, 22, 22, 22, 22, 23, 23, 23, 23, 23, 23, 24, 24, 24, 24, 24, 24, 25, 25, 25, 25, 25, 25, 25, 26, 26, 26, 26, 26, 26, 26, 26, 27, 27, 27, 27, 27, 27, 27, 27, 27, 27, 28, 28, 28, 28, 28, 28, 28, 28, 28, 28, 29, 29, 29, 29, 29, 29, 29, 29, 29, 29, 29, 29, 30, 30, 30, 30, 30, 30, 30, 30, 30, 30, 30, 30, 30, 30, 31, 31, 31, 31, 31, 31, 31, 31, 31, 31, 31, 31, 31, 31, 31};

__device__ __forceinline__ float bf2f(unsigned short b) { return __uint_as_float((unsigned)b << 16); }
__device__ __forceinline__ float wave_sum(float v) {
#pragma unroll
    for (int o = 1; o < 64; o <<= 1) v += __shfl_xor(v, o);
    return v;
}
__device__ __forceinline__ float wave_max(float v) {
#pragma unroll
    for (int o = 1; o < 64; o <<= 1) v = fmaxf(v, __shfl_xor(v, o));
    return v;
}
__device__ __forceinline__ float silu_f(float a) { return a / (1.0f + __expf(-a)); }
__device__ __forceinline__ float softplus_f(float v) { return fmaxf(v, 0.f) + log1pf(expf(-fabsf(v))); }

struct Frame {
    LAS unsigned char* lds;
    int tid, lane, wave, G, vcu;
    const float* in[22]; float* out; unsigned char* ws;
};

template <class RowMap>
__device__ __forceinline__ void p0_transpose_item(const float* W, int ldw, int nblk, const float* kscale, bf16* WT, int ldo, RowMap rm, LAS float* scr, int item, int lane) {
    const int kb = item / nblk, nb = item % nblk, k0 = 64 * kb, n0 = 32 * nb;
#pragma unroll 8
    for (int i = 0; i < 32; ++i) { const int kk = 2 * i + (lane >> 5); float v = W[(size_t)(k0 + kk) * ldw + n0 + (lane & 31)]; if (kscale) v *= kscale[k0 + kk]; scr[kk * 33 + (lane & 31)] = v; }
    LDS_WAIT(); asm volatile("" ::: "memory");
    const int c = lane & 7;
#pragma unroll
    for (int j = 0; j < 4; ++j) { const int n = (lane >> 3) + 8 * j; const LAS float* s = scr + (8 * c) * 33 + n;
        v4u o; o.x = pk2(s[0 * 33], s[1 * 33]); o.y = pk2(s[2 * 33], s[3 * 33]); o.z = pk2(s[4 * 33], s[5 * 33]); o.w = pk2(s[6 * 33], s[7 * 33]);
        *(GAS v4u*)(WT + (size_t)rm(n0 + n) * ldo + k0 + 8 * c) = o; }
    LDS_WAIT(); asm volatile("" ::: "memory");
}
struct RmId { __device__ __forceinline__ int operator()(int n) const { return n; } };
struct RmGU { int up; __device__ __forceinline__ int operator()(int n) const { return 8 * (n >> 2) + (n & 3) + 4 * up; } };

__device__ __forceinline__ void p0_prologue(Frame& F) {
    const float* x_p = F.in[0]; const float* x_s = F.in[1]; const float* norm1 = F.in[7]; const float* w_in = F.in[8]; const float* dt_bias = F.in[12];
    bf16* XN = (bf16*)(F.ws + WS_XN); float* DT = (float*)(F.ws + WS_DT);
    LAS float* wdt = (LAS float*)(F.lds);
    LAS float* scr = (LAS float*)(F.lds + 32768 + F.wave * 12288);
    for (int i = F.tid; i < 8192; i += NWAVES * 64) { const int k = i >> 3, j = i & 7; wdt[j * 1024 + k] = w_in[(size_t)k * LDW_IN + NPROJ + j]; }
    __syncthreads();
    const int gw = F.vcu * NWAVES + F.wave, NGW = F.G * NWAVES;
    for (int it = gw; it < 16 * 72; it += NGW) p0_transpose_item(F.in[8], LDW_IN, 72, (const float*)nullptr, (bf16*)(F.ws + WS_WIN), 1024, RmId{}, scr, it, F.lane);
    f32x4 w1[4];
#pragma unroll
    for (int j = 0; j < 4; ++j) w1[j] = ((const f32x4*)norm1)[64 * j + F.lane];
    for (int m = gw; m < MP; m += NGW) {
        GAS unsigned long long* o8 = (GAS unsigned long long*)(XN + (size_t)m * DM) + F.lane;
        if (m >= MREAL) {
#pragma unroll
            for (int j = 0; j < 4; ++j) o8[64 * j] = 0ull;
            continue; }
        const float* xrow = m < MPROMPT ? x_p + (size_t)m * DM : x_s + (size_t)(m - MPROMPT) * DM;
        const f32x4* xr = (const f32x4*)xrow + F.lane;
        f32x4 v[4]; float s = 0.f;
#pragma unroll
        for (int j = 0; j < 4; ++j) { v[j] = xr[64 * j]; s += (v[j][0] * v[j][0] + v[j][1] * v[j][1]) + (v[j][2] * v[j][2] + v[j][3] * v[j][3]); }
        const float rstd = 1.0f / sqrtf(wave_sum(s) * (1.0f / DM) + EPS);
        float d[8];
#pragma unroll
        for (int q = 0; q < 8; ++q) d[q] = 0.f;
#pragma unroll
        for (int j = 0; j < 4; ++j) { v[j] = v[j] * w1[j] * rstd;
#pragma unroll
            for (int q = 0; q < 8; ++q) { const f32x4 wq = *(const LAS f32x4*)(wdt + q * 1024 + 256 * j + 4 * F.lane); d[q] += (v[j][0] * wq[0] + v[j][1] * wq[1]) + (v[j][2] * wq[2] + v[j][3] * wq[3]); } }
#pragma unroll
        for (int q = 0; q < 8; ++q) d[q] = wave_sum(d[q]);
        float dsel = d[0];
#pragma unroll
        for (int q = 1; q < 8; ++q) dsel = (F.lane == q) ? d[q] : dsel;
        if (F.lane < 8) DT[(size_t)m * 8 + F.lane] = softplus_f(dsel + dt_bias[F.lane]);
#pragma unroll
        for (int j = 0; j < 4; ++j) o8[64 * j] = (unsigned long long)pk2(v[j][0], v[j][1]) | ((unsigned long long)pk2(v[j][2], v[j][3]) << 32);
    }
}


__device__ __forceinline__ void p0_deferred(Frame& F, int wrank, int nwranks) {
    LAS float* scr = (LAS float*)(F.lds + 32768 + F.wave * 12288);
    constexpr int I_OUT = 16 * 32, I_G = 16 * 88, I_D = 44 * 32, NITEMS = I_OUT + 2 * I_G + I_D;
    for (int it = wrank; it < NITEMS; it += nwranks) {
        int r = it;
        if (r < I_OUT) { p0_transpose_item(F.in[16], 1024, 32, (const float*)nullptr, (bf16*)(F.ws + WS_WOUT), 1024, RmId{}, scr, r, F.lane); continue; } r -= I_OUT;
        if (r < I_G) { p0_transpose_item(F.in[18], DFF, 88, F.in[17], (bf16*)(F.ws + WS_WGU), 1024, RmGU{0}, scr, r, F.lane); continue; } r -= I_G;
        if (r < I_G) { p0_transpose_item(F.in[19], DFF, 88, F.in[17], (bf16*)(F.ws + WS_WGU), 1024, RmGU{1}, scr, r, F.lane); continue; } r -= I_G;
        p0_transpose_item(F.in[20], 1024, 32, (const float*)nullptr, (bf16*)(F.ws + WS_WD), DFF, RmId{}, scr, r, F.lane);
    }
    const int gt = wrank * 64 + F.lane, NGT = nwranks * 64;
    for (int i = gt; i < NB * 4064; i += NGT) { const int b = i / 4064, r = i % 4064;
        ((f32x4*)(F.out + O_KS + (size_t)b * 16384))[r] = ((const f32x4*)(F.in[2] + (size_t)b * 16384 + 128))[r];
        ((f32x4*)(F.out + O_VS + (size_t)b * 16384))[r] = ((const f32x4*)(F.in[3] + (size_t)b * 16384 + 128))[r]; }
    for (int i = gt; i < NB * 512; i += NGT) { const int b = i / 512, r = i % 512;
        ((f32x4*)(F.out + O_CS + (size_t)b * 3072))[r] = ((const f32x4*)(F.in[4] + (size_t)b * 3072 + 1024))[r]; }
}
__device__ __forceinline__ void p3_attn_naive(Frame& F, int m_lo) {
    const bf16* PROJ = (const bf16*)(F.ws + WS_PROJ); bf16* MIX = (bf16*)(F.ws + WS_MIX);
    const float* ck = F.in[2]; const float* cv = F.in[3]; const float* relb = F.in[6]; const float* sinks = F.in[9];
    const int gw = F.vcu * NWAVES + F.wave, NGW = F.G * NWAVES, lane = F.lane;
    for (int task = m_lo * 8 + gw; task < MREAL * 8; task += NGW) { const int m = task >> 3, hh = task & 7, kvh = hh >> 2;
        const bool prompt = m < MPROMPT; const int t = m & (SEQ - 1), b = prompt ? (m >> 12) : (m - MPROMPT);
        float q[64];
        { const bf16* qp = PROJ + (size_t)m * NPROJ + C_Q + hh * 64;
#pragma unroll
          for (int d8 = 0; d8 < 8; ++d8) { const v4u w = *(const v4u*)(qp + d8 * 8);
#pragma unroll
              for (int e = 0; e < 4; ++e) { q[d8 * 8 + 2 * e] = __uint_as_float(w[e] << 16); q[d8 * 8 + 2 * e + 1] = __uint_as_float(w[e] & 0xffff0000u); } } }
        float s[2];
#pragma unroll
        for (int half = 0; half < 2; ++half) { const int i = lane + 64 * half; float acc = 0.f; bool valid = true;
            if (prompt) { const int kt = t - 127 + i; valid = kt >= 0;
                if (valid) { const bf16* kp = PROJ + (size_t)(m - 127 + i) * NPROJ + C_K + kvh * 64;
#pragma unroll
                    for (int d8 = 0; d8 < 8; ++d8) { const v4u w = *(const v4u*)(kp + d8 * 8);
#pragma unroll
                        for (int e = 0; e < 4; ++e) acc += q[d8 * 8 + 2 * e] * __uint_as_float(w[e] << 16) + q[d8 * 8 + 2 * e + 1] * __uint_as_float(w[e] & 0xffff0000u); } } }
            else if (i < 127) { const float* kp = ck + ((size_t)b * 128 + i + 1) * 128 + kvh * 64;
#pragma unroll
                for (int d4 = 0; d4 < 16; ++d4) { const f32x4 w = *(const f32x4*)(kp + d4 * 4); acc += (q[d4 * 4] * w[0] + q[d4 * 4 + 1] * w[1]) + (q[d4 * 4 + 2] * w[2] + q[d4 * 4 + 3] * w[3]); } }
            else { const bf16* kp = PROJ + (size_t)m * NPROJ + C_K + kvh * 64;
#pragma unroll
                for (int d8 = 0; d8 < 8; ++d8) { const v4u w = *(const v4u*)(kp + d8 * 8);
#pragma unroll
                    for (int e = 0; e < 4; ++e) acc += q[d8 * 8 + 2 * e] * __uint_as_float(w[e] << 16) + q[d8 * 8 + 2 * e + 1] * __uint_as_float(w[e] & 0xffff0000u); } }
            s[half] = valid ? acc * 0.125f + relb[BUCKET[127 - i] * 8 + hh] : -INFINITY; }
        const float sk = sinks[hh];
        const float mx = fmaxf(wave_max(fmaxf(s[0], s[1])), sk);
        float p0 = __expf(s[0] - mx), p1 = __expf(s[1] - mx);
        const float den = wave_sum(p0 + p1) + __expf(sk - mx), inv = 1.0f / den;
        p0 *= inv; p1 *= inv;
        float o = 0.f;
        for (int i = 0; i < 128; ++i) { const float p = __shfl(i < 64 ? p0 : p1, i & 63);
            float v = 0.f;
            if (prompt) { if (t - 127 + i >= 0) v = bf2f(PROJ[(size_t)(m - 127 + i) * NPROJ + C_V + kvh * 64 + lane]); }
            else if (i < 127) v = cv[((size_t)b * 128 + i + 1) * 128 + kvh * 64 + lane];
            else v = bf2f(PROJ[(size_t)m * NPROJ + C_V + kvh * 64 + lane]);
            o += p * v; }
        MIX[(size_t)m * 1024 + hh * 64 + lane] = (bf16)f2bf(o);
    }
}
typedef float f32x16 __attribute__((ext_vector_type(16)));
typedef unsigned long long u64;
__device__ __forceinline__ int crow(int r, int h) { return (r & 3) + 8 * (r >> 2) + 4 * h; }
__device__ __forceinline__ bf16x8 pack8(float a0, float a1, float a2, float a3, float a4, float a5, float a6, float a7) {
    v4u w; w.x = pk2(a0, a1); w.y = pk2(a2, a3); w.z = pk2(a4, a5); w.w = pk2(a6, a7); return __builtin_bit_cast(bf16x8, w);
}
constexpr int AT_KP = 144, AT_VP = 520;
constexpr int AT_K = 0, AT_V = 256 * AT_KP, AT_BIAS = AT_V + 64 * AT_VP, AT_LW = AT_BIAS + 3072, AT_END = AT_LW + 1024;
__device__ __forceinline__ void attn_unit(Frame& F, int b, int nblk, int kvh) {
    const bf16* PROJ = (const bf16*)(F.ws + WS_PROJ); bf16* MIX = (bf16*)(F.ws + WS_MIX);
    const float* relb = F.in[6]; const float* sinks = F.in[9];
    LAS unsigned char* L = F.lds;
    LAS float* BIASL = (LAS float*)(L + AT_BIAS); LAS float* LW = (LAS float*)(L + AT_LW);
    const int tid = F.tid, lane = F.lane, wave = F.wave, r32 = lane & 31, h = lane >> 5;
    constexpr float LOG2E = 1.4426950408889634f;
    { const int row = tid & 255; const int trow = (nblk - 1) * 128 + row; const bool ok = trow >= 0;
      const bf16* src = PROJ + (size_t)(b * SEQ + (ok ? trow : 0)) * NPROJ + kvh * 64;
#pragma unroll
      for (int k = 0; k < 4; ++k) { const int c16 = 2 * k + (tid >> 8);
          v4u kq = ok ? *(const v4u*)(src + C_K + c16 * 8) : (v4u){0u, 0u, 0u, 0u};
          v4u vq = ok ? *(const v4u*)(src + C_V + c16 * 8) : (v4u){0u, 0u, 0u, 0u};
          *(LAS v4u*)(L + AT_K + row * AT_KP + c16 * 16) = kq;
#pragma unroll
          for (int e = 0; e < 8; ++e) *(LAS unsigned short*)(L + AT_V + (c16 * 8 + e) * AT_VP + row * 2) = (unsigned short)(vq[e >> 1] >> (16 * (e & 1))); }
      for (int i = tid; i < 768; i += NWAVES * 64) { const int rr = i / 192, d = i % 192 - 32;
          BIASL[i] = (d >= 0 && d < 128) ? relb[BUCKET[d & 127] * 8 + kvh * 4 + rr] * LOG2E : 0.f; } }
    __syncthreads();
    const int r = wave >> 1, half = wave & 1, hh = kvh * 4 + r;
    const float sink2 = sinks[hh] * LOG2E;
#pragma unroll 1
    for (int qq = 0; qq < 2; ++qq) {
        const int q0 = half * 64 + qq * 32;
        const size_t mq = (size_t)b * SEQ + nblk * 128 + q0;
        bf16x8 qf[4];
#pragma unroll
        for (int ks = 0; ks < 4; ++ks) qf[ks] = *(const bf16x8*)(PROJ + (mq + r32) * NPROJ + C_Q + hh * 64 + ks * 16 + h * 8);
        f32x16 st[5];
#pragma unroll
        for (int kk = 0; kk < 5; ++kk) { st[kk] = (f32x16){0.f, 0.f, 0.f, 0.f, 0.f, 0.f, 0.f, 0.f, 0.f, 0.f, 0.f, 0.f, 0.f, 0.f, 0.f, 0.f};
            const LAS unsigned char* kp = L + AT_K + (q0 + kk * 32 + r32) * AT_KP + h * 16;
#pragma unroll
            for (int ks = 0; ks < 4; ++ks) { const bf16x8 kf = *(const LAS bf16x8*)(kp + ks * 32); st[kk] = __builtin_amdgcn_mfma_f32_32x32x16_bf16(kf, qf[ks], st[kk], 0, 0, 0); }
            __builtin_amdgcn_sched_barrier(0); }
        float mx = -INFINITY; const LAS float* bl = BIASL + r * 192 + 32 + r32 + 128 - 4 * h;
#pragma unroll
        for (int kk = 0; kk < 5; ++kk)
#pragma unroll
            for (int reg = 0; reg < 16; ++reg) { const int krel = kk * 32 + crow(reg, h);
                const int dist = r32 + 128 - krel; const int kj = q0 + krel;
                const bool valid = dist >= 0 && dist < 128 && (nblk > 0 || kj >= 128);
                const float s = valid ? st[kk][reg] * (0.125f * LOG2E) + bl[-(kk * 32 + (reg & 3) + 8 * (reg >> 2))] : -INFINITY;
                st[kk][reg] = s; mx = fmaxf(mx, s); }
        mx = fmaxf(mx, __shfl_xor(mx, 32)); mx = fmaxf(mx, sink2);
        float l = 0.f;
#pragma unroll
        for (int kk = 0; kk < 5; ++kk)
#pragma unroll
            for (int reg = 0; reg < 16; ++reg) { const float p = __builtin_amdgcn_exp2f(st[kk][reg] - mx); st[kk][reg] = p; l += p; }
        l += __shfl_xor(l, 32); l += __builtin_amdgcn_exp2f(sink2 - mx);
        if (h == 0) LW[wave * 32 + r32] = 1.0f / l;
        f32x16 o[2];
        o[0] = (f32x16){0.f, 0.f, 0.f, 0.f, 0.f, 0.f, 0.f, 0.f, 0.f, 0.f, 0.f, 0.f, 0.f, 0.f, 0.f, 0.f}; o[1] = o[0];
#pragma unroll
        for (int kk = 0; kk < 5; ++kk)
#pragma unroll
            for (int s = 0; s < 2; ++s) { const bf16x8 pf = pack8(st[kk][8 * s], st[kk][8 * s + 1], st[kk][8 * s + 2], st[kk][8 * s + 3], st[kk][8 * s + 4], st[kk][8 * s + 5], st[kk][8 * s + 6], st[kk][8 * s + 7]);
#pragma unroll
                for (int db = 0; db < 2; ++db) { const LAS unsigned char* vp = L + AT_V + (db * 32 + r32) * AT_VP + (q0 + kk * 32 + 16 * s + 4 * h) * 2;
                    const u64 lo = *(const LAS u64*)vp, hi = *(const LAS u64*)(vp + 16);
                    typedef u64 u64x2 __attribute__((ext_vector_type(2))); const u64x2 vv = {lo, hi};
                    o[db] = __builtin_amdgcn_mfma_f32_32x32x16_bf16(pf, __builtin_bit_cast(bf16x8, vv), o[db], 0, 0, 0); }
                __builtin_amdgcn_sched_barrier(0); }
        LDS_WAIT();
#pragma unroll
        for (int reg = 0; reg < 16; ++reg) { const int qi = crow(reg, h); const float inv = LW[wave * 32 + qi];
#pragma unroll
            for (int db = 0; db < 2; ++db) MIX[(mq + qi) * 1024 + hh * 64 + db * 32 + r32] = (bf16)f2bf(o[db][reg] * inv); }
    }
    __syncthreads();
}
constexpr size_t WS_STATES = 174 * MiB;
constexpr size_t WS_HPREV = 190 * MiB;
constexpr size_t WS_DEC = 28 * MiB + 512 * 1024;
static_assert(WS_HPREV + 16 * MiB <= WS_XC, "ws map (ssd)");
constexpr int SP = 272;
__device__ __forceinline__ float silu_fast(float a) { return a * __builtin_amdgcn_rcpf(1.0f + __expf(-a)); }

__device__ __forceinline__ void conv_task(const bf16* PROJ, long m0, int t0, int j0, int chx, const float* cw, const float* cb, float (&o)[4][8]) {
    float x[11][4];
#pragma unroll
    for (int k = 0; k < 11; ++k) { const int tok = t0 + j0 - 3 + k;
        if (tok >= 0) { const u64 q = *(const u64*)(PROJ + (size_t)(m0 + j0 - 3 + k) * NPROJ + C_XBC + chx);
#pragma unroll
            for (int e = 0; e < 4; ++e) x[k][e] = bf2f((unsigned short)(q >> (16 * e))); }
        else {
#pragma unroll
            for (int e = 0; e < 4; ++e) x[k][e] = 0.f; } }
    const f32x4 w0 = *(const f32x4*)(cw + chx), w1 = *(const f32x4*)(cw + 1024 + chx), w2 = *(const f32x4*)(cw + 2048 + chx), w3 = *(const f32x4*)(cw + 3072 + chx), bb = *(const f32x4*)(cb + chx);
#pragma unroll
    for (int jj = 0; jj < 8; ++jj)
#pragma unroll
        for (int e = 0; e < 4; ++e) o[e][jj] = silu_fast(bb[e] + w0[e] * x[jj][e] + w1[e] * x[jj + 1][e] + w2[e] * x[jj + 2][e] + w3[e] * x[jj + 3][e]);
}
__device__ __forceinline__ void chunk_cumsum(const float* DT, long m0, int hd, float A, int lane, float& cs0, float& cs1, float& dt0, float& dt1, float& cend) {
    dt0 = DT[(size_t)(m0 + 2 * lane) * 8 + hd]; dt1 = DT[(size_t)(m0 + 2 * lane + 1) * 8 + hd];
    const float a0 = dt0 * A, a1 = dt1 * A; float incl = a0 + a1;
#pragma unroll
    for (int o = 1; o < 64; o <<= 1) { const float t = __shfl_up(incl, o); if (lane >= o) incl += t; }
    const float ex = incl - (a0 + a1); cs0 = ex + a0; cs1 = ex + (a0 + a1); cend = __shfl(incl, 63);
}

__device__ __forceinline__ void ssd_part1_unit(Frame& F, int b, int c, int g) {
    const bf16* PROJ = (const bf16*)(F.ws + WS_PROJ); const float* DT = (const float*)(F.ws + WS_DT);
    bf16* STATES = (bf16*)(F.ws + WS_STATES); float* DEC = (float*)(F.ws + WS_DEC);
    const float* cw = F.in[10]; const float* cb = F.in[11]; const float* A_log = F.in[13];
    LAS unsigned char* L = F.lds; LAS unsigned char* XwT = L; LAS unsigned char* BT = L + 256 * SP; LAS float* WL = (LAS float*)(L + 384 * SP);
    const int lane = F.lane, wave = F.wave, r32 = lane & 31, h = lane >> 5;
    const long m0 = (long)b * SEQ + c * 128; const int t0 = c * 128;
    if (wave < 4) { const int hd = 4 * g + wave; float cs0, cs1, dt0, dt1, cend;
        chunk_cumsum(DT, m0, hd, -expf(A_log[hd]), lane, cs0, cs1, dt0, dt1, cend);
        WL[wave * 128 + 2 * lane] = dt0 * __expf(cend - cs0); WL[wave * 128 + 2 * lane + 1] = dt1 * __expf(cend - cs1);
        if (lane == 0) DEC[(b * 32 + c) * 8 + hd] = __expf(cend); }
    __syncthreads();
#pragma unroll 1
    for (int k = 0; k < 2; ++k) { const int tr = wave + 8 * k, cq = lane, j0 = tr * 8; float o[4][8];
        conv_task(PROJ, m0, t0, j0, g * 256 + 4 * cq, cw, cb, o);
        const LAS float* wl = WL + (cq >> 4) * 128 + j0; float w[8];
#pragma unroll
        for (int jj = 0; jj < 8; ++jj) w[jj] = wl[jj];
#pragma unroll
        for (int e = 0; e < 4; ++e) *(LAS bf16x8*)(XwT + (4 * cq + e) * SP + j0 * 2) = pack8(o[e][0] * w[0], o[e][1] * w[1], o[e][2] * w[2], o[e][3] * w[3], o[e][4] * w[4], o[e][5] * w[5], o[e][6] * w[6], o[e][7] * w[7]); }
    { const int tr = wave * 2 + h, cq = r32, j0 = tr * 8; float o[4][8];
        conv_task(PROJ, m0, t0, j0, 512 + g * 128 + 4 * cq, cw, cb, o);
#pragma unroll
        for (int e = 0; e < 4; ++e) *(LAS bf16x8*)(BT + (4 * cq + e) * SP + j0 * 2) = pack8(o[e][0], o[e][1], o[e][2], o[e][3], o[e][4], o[e][5], o[e][6], o[e][7]); }
    __syncthreads();
    const int r = wave >> 1, pb = wave & 1, hd = 4 * g + r;
    f32x16 acc[4];
#pragma unroll
    for (int nb = 0; nb < 4; ++nb) acc[nb] = (f32x16){0.f, 0.f, 0.f, 0.f, 0.f, 0.f, 0.f, 0.f, 0.f, 0.f, 0.f, 0.f, 0.f, 0.f, 0.f, 0.f};
    const LAS unsigned char* ap = XwT + (r * 64 + pb * 32 + r32) * SP + h * 16; const LAS unsigned char* bp = BT + r32 * SP + h * 16;
#pragma unroll
    for (int ks = 0; ks < 8; ++ks) { const bf16x8 a = *(const LAS bf16x8*)(ap + ks * 32);
#pragma unroll
        for (int nb = 0; nb < 4; ++nb) { const bf16x8 bb = *(const LAS bf16x8*)(bp + nb * 32 * SP + ks * 32); acc[nb] = __builtin_amdgcn_mfma_f32_32x32x16_bf16(a, bb, acc[nb], 0, 0, 0); } }
    bf16* sp = STATES + ((size_t)((b * 32 + c) * 8 + hd) * 64 + pb * 32) * 128 + r32;
#pragma unroll
    for (int reg = 0; reg < 16; ++reg)
#pragma unroll
        for (int nb = 0; nb < 4; ++nb) sp[(size_t)crow(reg, h) * 128 + nb * 32] = (bf16)f2bf(acc[nb][reg]);
    __syncthreads();
}

__device__ __forceinline__ void ssd_scan(Frame& F) {
    const bf16* STATES = (const bf16*)(F.ws + WS_STATES); bf16* HPREV = (bf16*)(F.ws + WS_HPREV); const float* DEC = (const float*)(F.ws + WS_DEC);
    const int gt = F.vcu * NWAVES * 64 + F.tid, NGT = F.G * NWAVES * 64;
    for (int e = gt; e < BATCH * 8 * 64 * 64; e += NGT) { const int n2 = e & 63, p = (e >> 6) & 63, hd = (e >> 12) & 7, b = e >> 15;
        float h0 = 0.f, h1 = 0.f; unsigned st[32];
#pragma unroll
        for (int c = 0; c < 32; ++c) st[c] = *(const unsigned*)(STATES + ((size_t)((b * 32 + c) * 8 + hd) * 64 + p) * 128 + 2 * n2);
#pragma unroll
        for (int c = 0; c < 32; ++c) { *(unsigned*)(HPREV + ((size_t)((b * 32 + c) * 8 + hd) * 64 + p) * 128 + 2 * n2) = pk2(h0, h1);
            const float d = DEC[(b * 32 + c) * 8 + hd]; h0 = h0 * d + __uint_as_float(st[c] << 16); h1 = h1 * d + __uint_as_float(st[c] & 0xffff0000u); }
        *(float2*)(F.out + O_SP + ((size_t)((b * 8 + hd) * 64 + p)) * 128 + 2 * n2) = make_float2(h0, h1); }
}

__device__ __forceinline__ void ssd_part2_unit(Frame& F, int b, int c, int g) {
    const bf16* PROJ = (const bf16*)(F.ws + WS_PROJ); const float* DT = (const float*)(F.ws + WS_DT); const bf16* HPREV = (const bf16*)(F.ws + WS_HPREV); bf16* MIX = (bf16*)(F.ws + WS_MIX);
    const float* cw = F.in[10]; const float* cb = F.in[11]; const float* A_log = F.in[13]; const float* Dsk = F.in[14]; const float* nw = F.in[15];
    LAS unsigned char* L = F.lds; LAS unsigned char* Btok = L; LAS unsigned char* Ctok = L + 128 * SP; LAS unsigned char* XT = L + 256 * SP;
    LAS float* CS = (LAS float*)(L + 512 * SP); LAS float* DTL = CS + 512; LAS float* RSQ = DTL + 512;
    const int lane = F.lane, wave = F.wave, r32 = lane & 31, h = lane >> 5;
    const long m0 = (long)b * SEQ + c * 128; const int t0 = c * 128;
    if (wave < 4) { const int hd = 4 * g + wave; float cs0, cs1, dt0, dt1, cend;
        chunk_cumsum(DT, m0, hd, -expf(A_log[hd]), lane, cs0, cs1, dt0, dt1, cend);
        CS[wave * 128 + 2 * lane] = cs0; CS[wave * 128 + 2 * lane + 1] = cs1; DTL[wave * 128 + 2 * lane] = dt0; DTL[wave * 128 + 2 * lane + 1] = dt1; }
#pragma unroll 1
    for (int k = 0; k < 2; ++k) { const int tr = wave + 8 * k, cq = lane, j0 = tr * 8; float o[4][8];
        conv_task(PROJ, m0, t0, j0, g * 256 + 4 * cq, cw, cb, o);
#pragma unroll
        for (int e = 0; e < 4; ++e) *(LAS bf16x8*)(XT + (4 * cq + e) * SP + j0 * 2) = pack8(o[e][0], o[e][1], o[e][2], o[e][3], o[e][4], o[e][5], o[e][6], o[e][7]); }
#pragma unroll 1
    for (int k = 0; k < 2; ++k) { const int tr = wave * 2 + h, cq = r32, j0 = tr * 8; float o[4][8];
        conv_task(PROJ, m0, t0, j0, 512 + k * 256 + g * 128 + 4 * cq, cw, cb, o);
        LAS unsigned char* dst = (k == 0 ? Btok : Ctok) + j0 * SP + cq * 8;
#pragma unroll
        for (int jj = 0; jj < 8; ++jj) *(LAS u64*)(dst + jj * SP) = (u64)pk2(o[0][jj], o[1][jj]) | ((u64)pk2(o[2][jj], o[3][jj]) << 32); }
    __syncthreads();
    const int r = wave >> 1, sel = wave & 1, hd = 4 * g + r; const float Dv = Dsk[hd];
    const LAS float* csr = CS + r * 128; const LAS float* dtr = DTL + r * 128;
    float vkeep[2][2][16];
#pragma unroll
    for (int ibk = 0; ibk < 2; ++ibk) {
        const int ib = sel ? (1 + ibk) : (3 * ibk);
        bf16x8 cf[8];
#pragma unroll
        for (int ks = 0; ks < 8; ++ks) cf[ks] = *(const LAS bf16x8*)(Ctok + (ib * 32 + r32) * SP + ks * 32 + h * 16);
        f32x16 ao[2], ay[2];
#pragma unroll
        for (int pb = 0; pb < 2; ++pb) { ao[pb] = (f32x16){0.f, 0.f, 0.f, 0.f, 0.f, 0.f, 0.f, 0.f, 0.f, 0.f, 0.f, 0.f, 0.f, 0.f, 0.f, 0.f}; ay[pb] = ao[pb]; }
#pragma unroll
        for (int pb = 0; pb < 2; ++pb) { const bf16* hp = HPREV + ((size_t)((b * 32 + c) * 8 + hd) * 64 + pb * 32 + r32) * 128 + h * 8;
#pragma unroll
            for (int ks = 0; ks < 8; ++ks) { const bf16x8 hv = *(const bf16x8*)(hp + ks * 16); ao[pb] = __builtin_amdgcn_mfma_f32_32x32x16_bf16(cf[ks], hv, ao[pb], 0, 0, 0); } }
        const float cs_i = csr[ib * 32 + r32];
#pragma unroll 1
        for (int jb = 0; jb <= ib; ++jb) {
            f32x16 gt = (f32x16){0.f, 0.f, 0.f, 0.f, 0.f, 0.f, 0.f, 0.f, 0.f, 0.f, 0.f, 0.f, 0.f, 0.f, 0.f, 0.f};
            const LAS unsigned char* bq = Btok + (jb * 32 + r32) * SP + h * 16;
#pragma unroll
            for (int ks = 0; ks < 8; ++ks) { const bf16x8 bf = *(const LAS bf16x8*)(bq + ks * 32); gt = __builtin_amdgcn_mfma_f32_32x32x16_bf16(bf, cf[ks], gt, 0, 0, 0); }
            float mv[16]; const LAS float* csj = csr + jb * 32 + 4 * h; const LAS float* dtj = dtr + jb * 32 + 4 * h; const int irel = (ib - jb) * 32 + r32 - 4 * h;
#pragma unroll
            for (int reg = 0; reg < 16; ++reg) { const int jo = (reg & 3) + 8 * (reg >> 2);
                const float e = __expf(cs_i - csj[jo]) * dtj[jo]; mv[reg] = (jo <= irel) ? gt[reg] * e : 0.f; }
            const bf16x8 mf0 = pack8(mv[0], mv[1], mv[2], mv[3], mv[4], mv[5], mv[6], mv[7]), mf1 = pack8(mv[8], mv[9], mv[10], mv[11], mv[12], mv[13], mv[14], mv[15]);
#pragma unroll
            for (int pb = 0; pb < 2; ++pb) { const LAS unsigned char* xp = XT + (r * 64 + pb * 32 + r32) * SP + (jb * 32 + 4 * h) * 2;
                typedef u64 u64x2 __attribute__((ext_vector_type(2)));
                const u64x2 x0 = {*(const LAS u64*)xp, *(const LAS u64*)(xp + 16)}, x1 = {*(const LAS u64*)(xp + 32), *(const LAS u64*)(xp + 48)};
                ay[pb] = __builtin_amdgcn_mfma_f32_32x32x16_bf16(mf0, __builtin_bit_cast(bf16x8, x0), ay[pb], 0, 0, 0);
                ay[pb] = __builtin_amdgcn_mfma_f32_32x32x16_bf16(mf1, __builtin_bit_cast(bf16x8, x1), ay[pb], 0, 0, 0); }
        }
        const LAS float* csi = csr + ib * 32 + 4 * h;
        const LAS unsigned char* xq = XT + (r * 64 + r32) * SP + (ib * 32 + 4 * h) * 2;
        const bf16* zp = PROJ + (size_t)(m0 + ib * 32 + 4 * h) * NPROJ + C_Z + g * 256 + r * 64 + r32;
#pragma unroll
        for (int reg = 0; reg < 16; ++reg) { const int io = (reg & 3) + 8 * (reg >> 2); const float ecs = __expf(csi[io]); float s = 0.f;
#pragma unroll
            for (int pb = 0; pb < 2; ++pb) { const float xs = bf2f(*(const LAS unsigned short*)(xq + pb * 32 * SP + io * 2));
                const float y = ay[pb][reg] + ecs * ao[pb][reg] + Dv * xs;
                const float z = bf2f(zp[(size_t)io * NPROJ + pb * 32]);
                const float v = y * silu_fast(z); vkeep[ibk][pb][reg] = v; s += v * v; }
            s += __shfl_xor(s, 1); s += __shfl_xor(s, 2); s += __shfl_xor(s, 4); s += __shfl_xor(s, 8); s += __shfl_xor(s, 16);
            if (r32 == 0) RSQ[r * 128 + ib * 32 + 4 * h + io] = s; }
    }
    __syncthreads();
#pragma unroll
    for (int ibk = 0; ibk < 2; ++ibk) { const int ib = sel ? (1 + ibk) : (3 * ibk);
        const LAS float* rq = RSQ + ib * 32 + 4 * h;
        bf16* op = MIX + (size_t)(m0 + ib * 32 + 4 * h) * 1024 + 512 + g * 256 + r * 64 + r32;
        const float w0 = nw[g * 256 + r * 64 + r32], w1 = nw[g * 256 + r * 64 + 32 + r32];
#pragma unroll
        for (int reg = 0; reg < 16; ++reg) { const int io = (reg & 3) + 8 * (reg >> 2);
            const float tot = (rq[io] + rq[128 + io]) + (rq[256 + io] + rq[384 + io]); const float rstd = 1.0f / sqrtf(tot * (1.0f / 256.0f) + EPS);
            op[(size_t)io * 1024] = (bf16)f2bf(vkeep[ibk][0][reg] * rstd * w0); op[(size_t)io * 1024 + 32] = (bf16)f2bf(vkeep[ibk][1][reg] * rstd * w1); } }
    __syncthreads();
}

__device__ __forceinline__ void ssm_sample_unit(Frame& F, int b, int g) {
    const bf16* PROJ = (const bf16*)(F.ws + WS_PROJ); const float* DT = (const float*)(F.ws + WS_DT); bf16* MIX = (bf16*)(F.ws + WS_MIX);
    const float* sconv = F.in[4]; const float* st0 = F.in[5]; const float* cw = F.in[10]; const float* cb = F.in[11]; const float* A_log = F.in[13]; const float* Dsk = F.in[14]; const float* nw = F.in[15];
    LAS float* XS = (LAS float*)F.lds; LAS float* BS = XS + 256; LAS float* CSm = BS + 128; LAS float* YL = CSm + 128; LAS float* RED = YL + 256;
    const int tid = F.tid, lane = F.lane, wave = F.wave; const size_t m = MPROMPT + b;
    {
        const int chx = tid < 256 ? g * 256 + tid : (tid < 384 ? 512 + g * 128 + (tid - 256) : 768 + g * 128 + (tid - 384));
        float a = cb[chx];
#pragma unroll
        for (int j = 0; j < 3; ++j) a += cw[j * 1024 + chx] * sconv[(size_t)b * 3072 + j * 1024 + chx];
        a += cw[3072 + chx] * bf2f(PROJ[m * NPROJ + C_XBC + chx]);
        XS[tid] = silu_fast(a); }
    __syncthreads();
    const int hl = lane >> 5, l32 = lane & 31;
#pragma unroll 1
    for (int it = 0; it < 16; ++it) { const int row = wave * 32 + it * 2 + hl, r = row >> 6, p = row & 63, hd = 4 * g + r;
        const float dt = DT[m * 8 + hd], A = -expf(A_log[hd]), dA = __expf(dt * A), x = XS[row], dx = dt * x;
        const size_t so = ((size_t)((b * 8 + hd) * 64 + p)) * 128 + 4 * l32;
        f32x4 hv = *(const f32x4*)(st0 + so); const f32x4 bv = *(const LAS f32x4*)(BS + 4 * l32), cv = *(const LAS f32x4*)(CSm + 4 * l32);
        hv = hv * dA + bv * dx; *(f32x4*)(F.out + O_SS + so) = hv;
        float y = (hv[0] * cv[0] + hv[1] * cv[1]) + (hv[2] * cv[2] + hv[3] * cv[3]);
        y += __shfl_xor(y, 1); y += __shfl_xor(y, 2); y += __shfl_xor(y, 4); y += __shfl_xor(y, 8); y += __shfl_xor(y, 16);
        if (l32 == 0) YL[row] = y + Dsk[hd] * x; }
    __syncthreads();
    float v = 0.f;
    if (tid < 256) { const float z = bf2f(PROJ[m * NPROJ + C_Z + g * 256 + tid]); v = YL[tid] * silu_fast(z); }
    const float ws = wave_sum(v * v); if (lane == 0) RED[wave] = ws;
    __syncthreads();
    if (tid < 256) { const float tot = (RED[0] + RED[1]) + (RED[2] + RED[3]); const float rstd = 1.0f / sqrtf(tot * (1.0f / 256.0f) + EPS);
        MIX[m * 1024 + 512 + g * 256 + tid] = (bf16)f2bf(v * rstd * nw[g * 256 + tid]); }
    __syncthreads();
}
__device__ __forceinline__ void copy_small_outputs(Frame& F) {
    const bf16* PROJ = (const bf16*)(F.ws + WS_PROJ);
    const int gt = F.vcu * NWAVES * 64 + F.tid, NGT = F.G * NWAVES * 64;
    for (int i = gt; i < BATCH * 128 * 128; i += NGT) { const int c = i & 127, j = (i >> 7) & 127, b = i >> 14; const size_t row = (size_t)b * SEQ + (SEQ - 128) + j;
        F.out[O_KP + i] = bf2f(PROJ[row * NPROJ + C_K + c]); F.out[O_VP + i] = bf2f(PROJ[row * NPROJ + C_V + c]); }
    for (int i = gt; i < BATCH * 3 * 1024; i += NGT) { const int c = i & 1023, j = (i >> 10) % 3, b = i / 3072; F.out[O_CP + i] = bf2f(PROJ[((size_t)b * SEQ + SEQ - 3 + j) * NPROJ + C_XBC + c]); }
    for (int i = gt; i < NB * 128; i += NGT) { const int c = i & 127, b = i >> 7; const size_t row = MPROMPT + b;
        F.out[O_KS + (size_t)b * 16384 + 127 * 128 + c] = bf2f(PROJ[row * NPROJ + C_K + c]); F.out[O_VS + (size_t)b * 16384 + 127 * 128 + c] = bf2f(PROJ[row * NPROJ + C_V + c]); }
    for (int i = gt; i < NB * 1024; i += NGT) { const int c = i & 1023, b = i >> 10; F.out[O_CS + (size_t)b * 3072 + 2048 + c] = bf2f(PROJ[(size_t)(MPROMPT + b) * NPROJ + C_XBC + c]); }
}
template <int MODE>
__device__ __forceinline__ void skinny_unit(Frame& F, int unit, const bf16* A, int lda, const bf16* Bt, int K, const float* base, float* out, bf16* xb, float* ssq) {
    const int rb = unit >> 4, cb = unit & 15, lane = F.lane, wave = F.wave, r32 = lane & 31, h = lane >> 5;
    const int kw = K / 8, k0 = wave * kw, nks = kw / 16;
    const bf16* ap = A + (size_t)(rb * 32 + r32) * lda + k0 + h * 8;
    const bf16* bp0 = Bt + (size_t)(cb * 64 + r32) * K + k0 + h * 8; const bf16* bp1 = bp0 + (size_t)32 * K;
    f32x16 acc0 = (f32x16){0.f, 0.f, 0.f, 0.f, 0.f, 0.f, 0.f, 0.f, 0.f, 0.f, 0.f, 0.f, 0.f, 0.f, 0.f, 0.f}, acc1 = acc0;
#pragma unroll 2
    for (int ks = 0; ks < nks; ++ks) { const bf16x8 a = *(const bf16x8*)(ap + ks * 16), b0 = *(const bf16x8*)(bp0 + ks * 16), b1 = *(const bf16x8*)(bp1 + ks * 16);
        acc0 = __builtin_amdgcn_mfma_f32_32x32x16_bf16(a, b0, acc0, 0, 0, 0); acc1 = __builtin_amdgcn_mfma_f32_32x32x16_bf16(a, b1, acc1, 0, 0, 0); }
    LAS float* red = (LAS float*)F.lds;
#pragma unroll
    for (int reg = 0; reg < 16; ++reg) { red[((wave * 2 + 0) * 16 + reg) * 64 + lane] = acc0[reg]; red[((wave * 2 + 1) * 16 + reg) * 64 + lane] = acc1[reg]; }
    __syncthreads();
    { const int row = F.tid >> 4, col = (F.tid & 15) * 4;
      const int reg = (row & 3) + 4 * (row >> 3), ln = (col & 31) + 32 * ((row >> 2) & 1), tile = col >> 5;
      f32x4 v = (f32x4){0.f, 0.f, 0.f, 0.f};
#pragma unroll
      for (int w = 0; w < 8; ++w) v += *(const LAS f32x4*)(red + ((w * 2 + tile) * 16 + reg) * 64 + ln);
      const size_t o = (size_t)(rb * 32 + row) * 1024 + cb * 64 + col;
      v += *(const f32x4*)(base + o);
      *(f32x4*)(out + o) = v;
      if (MODE == 0) { pg8::u32x2 w2; w2.x = pk2(v[0], v[1]); w2.y = pk2(v[2], v[3]); *(pg8::u32x2*)(xb + o) = w2;
          float s = (v[0] * v[0] + v[1] * v[1]) + (v[2] * v[2] + v[3] * v[3]);
          s += __shfl_xor(s, 1); s += __shfl_xor(s, 2); s += __shfl_xor(s, 4); s += __shfl_xor(s, 8);
          if ((F.tid & 15) == 0) ssq[(size_t)(rb * 32 + row) * 16 + cb] = s; } }
    __syncthreads();
}
__device__ __forceinline__ void p8_final_norm(Frame& F) {
    const float* wf = F.in[21];
    const int gw = F.vcu * NWAVES + F.wave, NGW = F.G * NWAVES;
    f32x4 w[4];
#pragma unroll
    for (int j = 0; j < 4; ++j) w[j] = ((const f32x4*)wf)[64 * j + F.lane];
    for (int m = gw; m < MREAL; m += NGW) { f32x4* xr = (f32x4*)(F.out + (size_t)m * DM) + F.lane; f32x4 v[4]; float s = 0.f;
#pragma unroll
        for (int j = 0; j < 4; ++j) { v[j] = xr[64 * j]; s += (v[j][0] * v[j][0] + v[j][1] * v[j][1]) + (v[j][2] * v[j][2] + v[j][3] * v[j][3]); }
        const float rstd = 1.0f / sqrtf(wave_sum(s) * (1.0f / DM) + EPS);
#pragma unroll
        for (int j = 0; j < 4; ++j) xr[64 * j] = v[j] * rstd * w[j]; }
}

struct Args { const float* in[22]; float* out; unsigned char* ws; int ph_lo, ph_hi; };
constexpr int N_PHASES = 9;
#ifndef MK_ONE_LAUNCH
#define MK_ONE_LAUNCH 1
#endif
__global__ void __launch_bounds__(NWAVES * 64, 2) hymba_fwd(Args args) {
    extern __shared__ __attribute__((aligned(16))) unsigned char lds[];
    Frame F;
    F.lds = (LAS unsigned char*)lds;
    F.tid = threadIdx.x; F.lane = F.tid & 63; F.wave = __builtin_amdgcn_readfirstlane(F.tid >> 6);
    F.G = gridDim.x; { const int bx = blockIdx.x; F.vcu = (F.G % 8 == 0) ? (bx % 8) * (F.G / 8) + bx / 8 : bx; }
#pragma unroll
    for (int i = 0; i < 22; ++i) F.in[i] = args.in[i];
    F.out = args.out; F.ws = args.ws;
    volatile LAS unsigned* MISC = (volatile LAS unsigned*)(F.lds + MISC_OFF);
    if (F.tid < 64) MISC[F.tid] = 0u;
    __syncthreads();
    gu32* ctl = (gu32*)(F.ws + WS_CTL);
    XcdBarrier bar; bar.bar = (unsigned*)(ctl + CW_BAR); bar.x = 0; bar.st = nullptr;
    const int lo = args.ph_lo, hi = args.ph_hi;
    if (hi - lo > 1) bar = xcd_barrier_post((unsigned*)(ctl + CW_BAR), MISC + 8);
#define IN(k) (lo <= (k) && (k) < hi)
#define SEAM(k) do { if (IN(k) && IN((k) + 1)) xcd_barrier(bar); } while (0)
    bf16* XN = (bf16*)(F.ws + WS_XN); bf16* PROJ = (bf16*)(F.ws + WS_PROJ); bf16* MIX = (bf16*)(F.ws + WS_MIX); bf16* HB = (bf16*)(F.ws + WS_PROJ);
    float* SSQ1 = (float*)(F.ws + WS_SSQ1);
    if (IN(0)) { p0_prologue(F); SEAM(0); }
    if (IN(1)) {
        pg8::Gemm g{XN, (const bf16*)(F.ws + WS_WIN), MP, NPROJ, DM}; pg8::StaticOrder S; S.init(MP, NPROJ, F.G, (int)blockIdx.x);
        pg8::EpiStoreBf16 E{PROJ, NPROJ};
        pg8::gemm_phase<pg8::EpiStoreBf16, pg8::StaticOrder, true, true>(F.lds + RING_OFF, g, S, E);
        { const int nwg = (MP / 256) * (NPROJ / 256), extra = nwg % F.G;
          if ((int)blockIdx.x >= extra) p0_deferred(F, ((int)blockIdx.x - extra) * NWAVES + F.wave, (F.G - extra) * NWAVES); }
        SEAM(1);
    }
    if (IN(2)) { for (int u = F.vcu; u < 256; u += F.G) { ssd_part1_unit(F, u >> 6, (u >> 1) & 31, u & 1); attn_unit(F, u >> 6, (u >> 1) & 31, u & 1); } copy_small_outputs(F); SEAM(2); }
    if (IN(3)) { ssd_scan(F); for (int u = F.vcu; u < 256; u += F.G) ssm_sample_unit(F, u >> 1, u & 1); p3_attn_naive(F, MPROMPT); SEAM(3); }
    if (IN(4)) { for (int u = F.vcu; u < 256; u += F.G) ssd_part2_unit(F, u >> 6, (u >> 1) & 31, u & 1); SEAM(4); }
    if (IN(5)) {
        pg8::Gemm g{MIX, (const bf16*)(F.ws + WS_WOUT), MPROMPT, DM, DM}; pg8::StaticOrder S; S.init(MPROMPT, DM, F.G, (int)blockIdx.x);
        pg8::EpiResid E{F.in[0], F.in[1], MPROMPT, F.out, XN, SSQ1, MREAL};
        pg8::gemm_phase<pg8::EpiResid, pg8::StaticOrder, true, true>(F.lds + RING_OFF, g, S, E);
        for (int u = F.vcu; u < 64; u += F.G) skinny_unit<0>(F, u, MIX + (size_t)MPROMPT * DM, DM, (const bf16*)(F.ws + WS_WOUT), DM, F.in[1], F.out + (size_t)MPROMPT * DM, XN + (size_t)MPROMPT * DM, SSQ1 + (size_t)MPROMPT * 16);
        SEAM(5);
    }
    if (IN(6)) {
        pg8::Gemm g{XN, (const bf16*)(F.ws + WS_WGU), MP, NGU, DM}; pg8::StaticOrder S; S.init(MP, NGU, F.G, (int)blockIdx.x);
        pg8::EpiSwiglu E{HB, DFF, SSQ1, EPS};
        pg8::gemm_phase<pg8::EpiSwiglu, pg8::StaticOrder, true, true>(F.lds + RING_OFF, g, S, E);
        SEAM(6);
    }
    if (IN(7)) {
        pg8::Gemm g{HB, (const bf16*)(F.ws + WS_WD), MPROMPT, DM, DFF}; pg8::StaticOrder S; S.init(MPROMPT, DM, F.G, (int)blockIdx.x);
        pg8::EpiResid E{F.out, F.out, MP, F.out, nullptr, nullptr, MREAL};
        pg8::gemm_phase<pg8::EpiResid, pg8::StaticOrder, true, true>(F.lds + RING_OFF, g, S, E);
        for (int u = F.vcu; u < 64; u += F.G) skinny_unit<1>(F, u, HB + (size_t)MPROMPT * DFF, DFF, (const bf16*)(F.ws + WS_WD), DFF, F.out + (size_t)MPROMPT * DM, F.out + (size_t)MPROMPT * DM, (bf16*)nullptr, (float*)nullptr);
        SEAM(7);
    }
    if (IN(8)) { p8_final_norm(F); }
#undef IN
#undef SEAM
}

extern "C" void kernel_launch(void* const* d_in, const int* in_sizes, int n_in, void* d_out, int out_size, void* d_ws, size_t ws_size, hipStream_t stream) {
    static int grid = 0;
    if (grid == 0) {
        if (n_in != 22 || (size_t)out_size != O_END || ws_size < WS_END) { fprintf(stderr, "kernel_launch: unexpected shapes (n_in %d out %d ws %zu)\n", n_in, out_size, ws_size); grid = -1; return; }
        int dev = 0, cus = 0;
        if (hipGetDevice(&dev) != hipSuccess || hipDeviceGetAttribute(&cus, hipDeviceAttributeMultiprocessorCount, dev) != hipSuccess) { grid = -1; return; }
        if (hipFuncSetAttribute((const void*)hymba_fwd, hipFuncAttributeMaxDynamicSharedMemorySize, LDS_BYTES) != hipSuccess) { fprintf(stderr, "kernel_launch: hipFuncSetAttribute failed\n"); grid = -1; return; }
        int per_cu = 0;
        if (hipOccupancyMaxActiveBlocksPerMultiprocessor(&per_cu, (const void*)hymba_fwd, NWAVES * 64, LDS_BYTES) != hipSuccess || per_cu < 1) fprintf(stderr, "kernel_launch: occupancy query reports %d\n", per_cu);
        (void)hipGetLastError();
        grid = cus;
    }
    if (grid < 0) return;
    if (hipMemsetAsync((char*)d_ws + WS_CTL, 0, CTL_ZERO_BYTES, stream) != hipSuccess) return;
    Args a{};
    for (int i = 0; i < 22; ++i) a.in[i] = (const float*)d_in[i];
    a.out = (float*)d_out; a.ws = (unsigned char*)d_ws;
#if MK_ONE_LAUNCH
    a.ph_lo = 0; a.ph_hi = N_PHASES;
    hipLaunchKernelGGL(hymba_fwd, dim3(grid), dim3(NWAVES * 64), LDS_BYTES, stream, a);
#else
    for (int p = 0; p < N_PHASES; ++p) { a.ph_lo = p; a.ph_hi = p + 1; hipLaunchKernelGGL(hymba_fwd, dim3(grid), dim3(NWAVES * 64), LDS_BYTES, stream, a); }
#endif
}
```
